# Optimizing an MI355X kernel written in HIP

```python
import math
import jax, jax.numpy as jnp
from jax import lax
import numpy as np

D_MODEL = 1024
BATCH = 8
SEQ = 2048
DEPTH = 2

HEAD_DIM = 64
HEADS_PER_GROUP = 4
DILATION_PATTERNS = ((128, 1), (512, 4), (2048, 16))
N_DIL_GROUPS = len(DILATION_PATTERNS)
N_ATTN_HEADS = N_DIL_GROUPS * HEADS_PER_GROUP
ATTN_WIDTH = N_ATTN_HEADS * HEAD_DIM
ATTN_OUT_WIDTH = HEADS_PER_GROUP * HEAD_DIM
POOL_WINDOWS = (2, 4, 8, 16)
POOL_GROUP_WIDTH = 128
POOL_WIDTH = len(POOL_WINDOWS) * POOL_GROUP_WIDTH
N_BRANCHES = 2
IN_WIDTH = 3 * ATTN_WIDTH + POOL_WIDTH + N_BRANCHES * D_MODEL
N_BUCKETS = 32
MAX_DISTANCE = 1024
N_EXPERT_GROUPS = 8
EXPERTS_PER_GROUP = 8
N_EXPERTS = N_EXPERT_GROUPS * EXPERTS_PER_GROUP
TOP_K_IN_GROUP = 2
D_EXPERT = 512
MOE_BLOCK = 128
EPS = 1e-6
NEG_INF = -1e30

kernel_name = "hybrid_dilated_pool_hiermoe_encoder"


def rmsnorm(x, g):
    xf = x.astype(jnp.float32)
    r = lax.rsqrt(jnp.mean(xf * xf, axis=-1, keepdims=True) + EPS)
    return (xf * r).astype(x.dtype) * g


def t5_bucket(rel):
    nb = N_BUCKETS // 2
    ret = jnp.where(rel > 0, nb, 0)
    n = jnp.abs(rel)
    max_exact = nb // 2
    nf = jnp.maximum(n, max_exact).astype(jnp.float32)
    large = max_exact + (jnp.log(nf / max_exact) / math.log(MAX_DISTANCE / max_exact)
                         * (nb - max_exact)).astype(jnp.int32)
    large = jnp.minimum(large, nb - 1)
    return ret + jnp.where(n < max_exact, n, large)


def dilated_band_attention(q, k, v, bias_tab, dilation, n_side):
    B, S, H, Dh = q.shape
    L = S // dilation
    blk = n_side
    nb = -(-L // blk)
    Lp = nb * blk

    def to_sub(t):
        t = t.reshape(B, L, dilation, H, Dh).transpose(0, 2, 1, 3, 4)
        return jnp.pad(t, ((0, 0), (0, 0), (0, Lp - L), (0, 0), (0, 0)))

    def key_blocks(t):
        tp = jnp.pad(to_sub(t), ((0, 0), (0, 0), (blk, blk), (0, 0), (0, 0)))
        tp = tp.reshape(B, dilation, nb + 2, blk, H, Dh)
        return jnp.concatenate([tp[:, :, :-2], tp[:, :, 1:-1], tp[:, :, 2:]], axis=3)

    qs = to_sub(q).reshape(B, dilation, nb, blk, H, Dh)
    kb = key_blocks(k)
    vb = key_blocks(v)

    a = jnp.arange(blk)[:, None]
    c = jnp.arange(3 * blk)[None, :]
    rel = c - blk - a
    key_idx = jnp.arange(nb)[:, None, None] * blk - blk + c[None]
    valid = (jnp.abs(rel) <= n_side)[None] & (key_idx >= 0) & (key_idx < L)
    pos_bias = bias_tab[t5_bucket(rel * dilation)].transpose(2, 0, 1).astype(jnp.float32)

    scale = HEAD_DIM ** -0.5
    logits = jnp.einsum('bgnqhd,bgnkhd->bgnhqk', qs, kb,
                        preferred_element_type=jnp.float32) * scale + pos_bias
    logits = jnp.where(valid[:, None], logits, NEG_INF)
    m = jnp.max(logits, axis=-1, keepdims=True)
    p = jnp.exp(logits - m)
    den = jnp.sum(p, axis=-1, keepdims=True)
    o = jnp.einsum('bgnhqk,bgnkhd->bgnqhd', (p / den).astype(v.dtype), vb)
    lse = (m + jnp.log(den))[..., 0]

    o = o.reshape(B, dilation, Lp, H, Dh)[:, :, :L].transpose(0, 2, 1, 3, 4).reshape(B, S, H, Dh)
    lse = lse.transpose(0, 1, 2, 4, 3).reshape(B, dilation, Lp, H)[:, :, :L]
    lse = lse.transpose(0, 2, 1, 3).reshape(B, S, H)
    return o, lse


def dilated_attention_mixture(q, k, v, rel_bias):
    B, S = q.shape[:2]
    outs, lses = [], []
    for gi, (window, dilation) in enumerate(DILATION_PATTERNS):
        hs = slice(gi * HEADS_PER_GROUP, (gi + 1) * HEADS_PER_GROUP)
        n_side = window // (2 * dilation)
        o, lse = dilated_band_attention(q[:, :, hs], k[:, :, hs], v[:, :, hs],
                                        rel_bias[:, hs], dilation, n_side)
        outs.append(o)
        lses.append(lse)
    w = jax.nn.softmax(jnp.stack(lses, axis=0), axis=0)
    o = jnp.sum(w[..., None].astype(q.dtype) * jnp.stack(outs, axis=0), axis=0)
    return o.reshape(B, S, ATTN_OUT_WIDTH)


def multiscale_pool(u, pool_w, pool_scale):
    B, S, _ = u.shape
    uf = u.astype(jnp.float32)
    cs = jnp.concatenate([jnp.zeros((B, 1, POOL_WIDTH), jnp.float32),
                          jnp.cumsum(uf, axis=1)], axis=1)
    pos = jnp.arange(S)
    outs = []
    for gi, w in enumerate(POOL_WINDOWS):
        sl = slice(gi * POOL_GROUP_WIDTH, (gi + 1) * POOL_GROUP_WIDTH)
        lo = jnp.maximum(pos - w // 2, 0)
        hi = jnp.minimum(pos + w - w // 2, S)
        csg = cs[..., sl]
        mean = (csg[:, hi] - csg[:, lo]) / (hi - lo).astype(jnp.float32)[None, :, None]
        outs.append(mean - uf[..., sl])
    pooled = jnp.stack(outs, axis=2).astype(u.dtype)
    mixed = jnp.einsum('bsgc,gce->bsge', pooled, pool_w).reshape(B, S, POOL_WIDTH)
    return mixed * pool_scale


def hybrid_mixer(xn, w_in, rel_bias, pool_w, pool_scale, w_proj_attn, w_proj_pool, w_out):
    B, S, D = xn.shape
    proj = xn @ w_in
    q, k, v, u, gates = jnp.split(
        proj, [ATTN_WIDTH, 2 * ATTN_WIDTH, 3 * ATTN_WIDTH, 3 * ATTN_WIDTH + POOL_WIDTH], axis=-1)
    q = q.reshape(B, S, N_ATTN_HEADS, HEAD_DIM)
    k = k.reshape(B, S, N_ATTN_HEADS, HEAD_DIM)
    v = v.reshape(B, S, N_ATTN_HEADS, HEAD_DIM)
    y_attn = dilated_attention_mixture(q, k, v, rel_bias) @ w_proj_attn
    y_pool = multiscale_pool(u, pool_w, pool_scale) @ w_proj_pool
    g = jax.nn.sigmoid(gates.astype(jnp.float32)).astype(xn.dtype).reshape(B, S, N_BRANCHES, D)
    y = g[:, :, 0] * y_attn + g[:, :, 1] * y_pool
    return y @ w_out


def hierarchical_moe(xn, w_router_group, w_router_expert, w_gate_e, w_up_e, w_down_e):
    B, S, D = xn.shape
    T = B * S
    xt = xn.reshape(T, D)
    g_logits = (xt @ w_router_group).astype(jnp.float32)
    g_prob = jax.nn.softmax(g_logits, axis=-1)
    g_idx = jnp.argmax(g_logits, axis=-1)
    g_p = jnp.take_along_axis(g_prob, g_idx[:, None], axis=1)[:, 0]
    e_all = jnp.einsum('td,gde->tge', xt, w_router_expert).astype(jnp.float32)
    e_logits = jnp.take_along_axis(e_all, g_idx[:, None, None], axis=1)[:, 0]
    top_val, top_idx = lax.top_k(e_logits, TOP_K_IN_GROUP)
    comb_w = g_p[:, None] * jax.nn.softmax(top_val, axis=-1)
    expert_id = g_idx[:, None].astype(jnp.int32) * EXPERTS_PER_GROUP + top_idx.astype(jnp.int32)

    A = T * TOP_K_IN_GROUP
    flat_e = expert_id.reshape(A)
    flat_t = jnp.repeat(jnp.arange(T, dtype=jnp.int32), TOP_K_IN_GROUP)
    flat_w = comb_w.reshape(A)
    se, st, sw = lax.sort((flat_e, flat_t, flat_w), num_keys=1, is_stable=True)
    counts = jnp.bincount(flat_e, length=N_EXPERTS)
    offsets = jnp.cumsum(counts) - counts
    padded = (counts + MOE_BLOCK - 1) // MOE_BLOCK * MOE_BLOCK
    padded_end = jnp.cumsum(padded)
    padded_off = padded_end - padded
    dest = padded_off[se] + (jnp.arange(A, dtype=jnp.int32) - offsets[se])
    P = A + N_EXPERTS * MOE_BLOCK
    n_blk = P // MOE_BLOCK
    x_pad = jnp.zeros((P, D), xt.dtype).at[dest].set(xt[st])
    blk_start = jnp.arange(n_blk, dtype=jnp.int32) * MOE_BLOCK
    blk_expert = jnp.minimum(jnp.searchsorted(padded_end, blk_start, side='right'),
                             N_EXPERTS - 1).astype(jnp.int32)

    def expert_block(args):
        xb, e = args
        h = jax.nn.silu(xb @ w_gate_e[e]) * (xb @ w_up_e[e])
        return h @ w_down_e[e]

    y_pad = lax.map(expert_block, (x_pad.reshape(n_blk, MOE_BLOCK, D), blk_expert)).reshape(P, D)
    y = y_pad[dest] * sw[:, None].astype(xt.dtype)
    out = jax.ops.segment_sum(y, st, num_segments=T)
    return out.reshape(B, S, D)


def setup_inputs(seed: int = 0) -> dict:
    key = jax.random.key(seed)
    ks = jax.random.split(key, 16)
    f32 = jnp.float32
    nrm = lambda k, shape, fan_in: jax.random.normal(k, shape, f32) * (fan_in ** -0.5)
    return {
        "x": jax.random.normal(ks[0], (BATCH, SEQ, D_MODEL), f32),
        "rel_bias": jax.random.normal(ks[1], (N_BUCKETS, N_ATTN_HEADS), f32) * 0.3,
        "norm_mix_g": 1.0 + 0.02 * jax.random.normal(ks[2], (DEPTH, D_MODEL), f32),
        "w_in": nrm(ks[3], (DEPTH, D_MODEL, IN_WIDTH), D_MODEL),
        "pool_w": nrm(ks[4], (DEPTH, len(POOL_WINDOWS), POOL_GROUP_WIDTH, POOL_GROUP_WIDTH), POOL_GROUP_WIDTH),
        "pool_scale": 1.0 + 0.1 * jax.random.normal(ks[5], (DEPTH, POOL_WIDTH), f32),
        "w_proj_attn": nrm(ks[6], (DEPTH, ATTN_OUT_WIDTH, D_MODEL), ATTN_OUT_WIDTH),
        "w_proj_pool": nrm(ks[7], (DEPTH, POOL_WIDTH, D_MODEL), POOL_WIDTH),
        "w_out": nrm(ks[8], (DEPTH, D_MODEL, D_MODEL), D_MODEL),
        "norm_ffn_g": 1.0 + 0.02 * jax.random.normal(ks[9], (DEPTH, D_MODEL), f32),
        "w_router_group": nrm(ks[10], (DEPTH, D_MODEL, N_EXPERT_GROUPS), D_MODEL),
        "w_router_expert": nrm(ks[11], (DEPTH, N_EXPERT_GROUPS, D_MODEL, EXPERTS_PER_GROUP), D_MODEL),
        "w_gate_e": nrm(ks[12], (DEPTH, N_EXPERTS, D_MODEL, D_EXPERT), D_MODEL),
        "w_up_e": nrm(ks[13], (DEPTH, N_EXPERTS, D_MODEL, D_EXPERT), D_MODEL),
        "w_down_e": nrm(ks[14], (DEPTH, N_EXPERTS, D_EXPERT, D_MODEL), D_EXPERT),
        "norm_final_g": 1.0 + 0.02 * jax.random.normal(ks[15], (D_MODEL,), f32),
    }


def reference(x, rel_bias, norm_mix_g, w_in, pool_w, pool_scale, w_proj_attn, w_proj_pool,
              w_out, norm_ffn_g, w_router_group, w_router_expert, w_gate_e, w_up_e, w_down_e,
              norm_final_g):
    h = x
    for l in range(DEPTH):
        h = h + hybrid_mixer(rmsnorm(h, norm_mix_g[l]), w_in[l], rel_bias, pool_w[l],
                             pool_scale[l], w_proj_attn[l], w_proj_pool[l], w_out[l])
        h = h + hierarchical_moe(rmsnorm(h, norm_ffn_g[l]), w_router_group[l],
                                 w_router_expert[l], w_gate_e[l], w_up_e[l], w_down_e[l])
    return rmsnorm(h, norm_final_g)
```

```cpp
#include <hip/hip_runtime.h>
#include <hip/hip_cooperative_groups.h>
#include <cstdio>
#include <cstdint>

constexpr int NB_ = 8, SEQ = 2048, T = NB_ * SEQ, D = 1024, DEPTH = 2;
constexpr int HD = 64, HPG = 4, NH = 12, AW = 768, AOW = 256;
constexpr int PW = 512, PGW = 128;
constexpr int NIN = 4864, COL_K = 768, COL_V = 1536, COL_U = 2304, COL_G = 2816;
constexpr int NEG = 8, EPG = 8, NE = 64, DE = 512;
constexpr int A2W = AOW + PW;
constexpr int PTILE = 256;
constexpr int PMAX_TILES = T * 2 / PTILE + NE;
constexpr int PMAX = PMAX_TILES * PTILE;
constexpr float EPS = 1e-6f;
constexpr int G = 256;
constexpr int NTHR = 512, NWAVES = 8;

typedef unsigned short bf16_t;
typedef float f32x4 __attribute__((ext_vector_type(4)));
typedef unsigned u32x4 __attribute__((ext_vector_type(4)));
typedef unsigned u32x2 __attribute__((ext_vector_type(2)));
#define LAS __attribute__((address_space(3)))
#define GAS __attribute__((address_space(1)))

constexpr size_t MiB = 1u << 20;
constexpr size_t WS_CTL = 0;
constexpr size_t WS_XN = 1 * MiB;
constexpr size_t WS_PROJ = WS_XN + (size_t)T * D * 2;
constexpr size_t WS_XPAD = WS_PROJ;
constexpr size_t WS_HB = WS_XPAD + (size_t)PMAX * D * 2;
constexpr size_t WS_A2 = WS_PROJ + (size_t)T * NIN * 2;
constexpr size_t WS_Y = WS_A2 + (size_t)T * A2W * 2;
constexpr size_t WS_H = WS_Y + (size_t)T * D * 2;
constexpr size_t WS_YPAD = WS_H + (size_t)T * D * 4;
constexpr size_t WS_Y1 = WS_YPAD;
constexpr size_t WS_OG = WS_XN;
constexpr size_t WS_LSE = WS_OG + (size_t)3 * T * AOW * 2;
constexpr size_t WS_WPC = WS_YPAD + (size_t)PMAX * D * 2;
constexpr size_t WS_END0 = WS_WPC + (size_t)DEPTH * D * PW * 2;
constexpr size_t WS_WIN = WS_END0;
constexpr size_t WS_WP = WS_WIN + (size_t)DEPTH * NIN * D * 2;
constexpr size_t WS_WOUT = WS_WP + (size_t)DEPTH * D * A2W * 2;
constexpr size_t WS_WR = WS_WOUT + (size_t)DEPTH * D * D * 2;
constexpr size_t WS_END = WS_WR + (size_t)DEPTH * 2 * 32 * 5 * 64 * 16;
static_assert(WS_HB + (size_t)PMAX * DE * 2 <= WS_A2, "XPAD+HB alias PROJ");
static_assert((size_t)T * D * 4 <= (size_t)PMAX * D * 2, "Y1 aliases YPAD");
constexpr size_t CT_EID = 0;
constexpr size_t CT_CW = 128 * 1024;
constexpr size_t CT_DEST = 256 * 1024;
constexpr size_t CT_HIST = 384 * 1024;
constexpr size_t CT_TILEE = 448 * 1024;
constexpr size_t CT_META = 450 * 1024;
constexpr size_t CT_BAR = 512 * 1024;
constexpr size_t CT_BAR_BYTES = 24 * 1024;
constexpr size_t CT_PANEL = CT_BAR + 16 * 1024;
constexpr size_t CT_READY = CT_BAR + 14 * 1024;
constexpr size_t CT_RSTD = 576 * 1024;
constexpr size_t CT_RS = 832 * 1024;
constexpr size_t CT_SRC = 640 * 1024;

struct Ctx {
    const float *x, *rel_bias, *norm_mix_g, *w_in, *pool_w, *pool_scale, *w_proj_attn, *w_proj_pool, *w_out, *norm_ffn_g, *w_rg, *w_re, *w_gate, *w_up, *w_down, *norm_final_g;
    float* out;
    unsigned char* ws;
    __device__ __host__ bf16_t* XN() const { return (bf16_t*)(ws + WS_XN); }
    __device__ __host__ bf16_t* PROJ() const { return (bf16_t*)(ws + WS_PROJ); }
    __device__ __host__ bf16_t* HB() const { return (bf16_t*)(ws + WS_HB); }
    __device__ __host__ bf16_t* A2() const { return (bf16_t*)(ws + WS_A2); }
    __device__ __host__ bf16_t* Y() const { return (bf16_t*)(ws + WS_Y); }
    __device__ __host__ bf16_t* H() const { return (bf16_t*)(ws + WS_H); }
    __device__ __host__ float* RSTDM() const { return (float*)(ws + WS_H + (size_t)T * D * 2); }
    __device__ __host__ bf16_t* YPAD() const { return (bf16_t*)(ws + WS_YPAD); }
    __device__ __host__ bf16_t* OG() const { return (bf16_t*)(ws + WS_OG); }
    __device__ __host__ float* LSE() const { return (float*)(ws + WS_LSE); }
    __device__ __host__ bf16_t* WIN() const { return (bf16_t*)(ws + WS_WIN); }
    __device__ __host__ bf16_t* WP() const { return (bf16_t*)(ws + WS_WP); }
    __device__ __host__ bf16_t* WOUT() const { return (bf16_t*)(ws + WS_WOUT); }
    __device__ __host__ bf16_t* WR() const { return (bf16_t*)(ws + WS_WR); }
    __device__ __host__ float* RSTD() const { return (float*)(ws + WS_CTL + CT_RSTD); }
    __device__ __host__ int* SRC() const { return (int*)(ws + WS_CTL + CT_SRC); }
    __device__ __host__ float* RS() const { return (float*)(ws + WS_CTL + CT_RS); }
    __device__ __host__ int* READY() const { return (int*)(ws + WS_CTL + CT_READY); }
    __device__ __host__ int* PANEL() const { return (int*)(ws + WS_CTL + CT_PANEL); }
    __device__ __host__ int* EID() const { return (int*)(ws + WS_CTL + CT_EID); }
    __device__ __host__ float* CW() const { return (float*)(ws + WS_CTL + CT_CW); }
    __device__ __host__ int* DEST() const { return (int*)(ws + WS_CTL + CT_DEST); }
    __device__ __host__ int* HIST() const { return (int*)(ws + WS_CTL + CT_HIST); }
    __device__ __host__ int* TILEE() const { return (int*)(ws + WS_CTL + CT_TILEE); }
    __device__ __host__ int* META() const { return (int*)(ws + WS_CTL + CT_META); }
};

__device__ __forceinline__ float bf2f(bf16_t v) { return __uint_as_float((unsigned)v << 16); }
__device__ __forceinline__ unsigned f2bf(float f) { unsigned u = __float_as_uint(f); return (u + 0x7fffu + ((u >> 16) & 1u)) >> 16; }
typedef float f32x2_t __attribute__((ext_vector_type(2))); typedef __bf16 bf16x2_t __attribute__((ext_vector_type(2)));
__device__ __forceinline__ unsigned pk2(float lo, float hi) { f32x2_t v = {lo, hi}; bf16x2_t b = __builtin_convertvector(v, bf16x2_t); return __builtin_bit_cast(unsigned, b); }
template <int MASK> __device__ __forceinline__ float swz_xor(float v) { return __int_as_float(__builtin_amdgcn_ds_swizzle(__float_as_int(v), (MASK << 10) | 0x1f)); }
__device__ __forceinline__ float sum_x32(float v) {
    const auto r = __builtin_amdgcn_permlane32_swap(__float_as_uint(v), __float_as_uint(v), false, false); return __uint_as_float(r[0]) + __uint_as_float(r[1]); }
__device__ __forceinline__ float max_x32(float v) {
    const auto r = __builtin_amdgcn_permlane32_swap(__float_as_uint(v), __float_as_uint(v), false, false); return fmaxf(__uint_as_float(r[0]), __uint_as_float(r[1])); }
__device__ __forceinline__ float wave_sum(float v) { v += swz_xor<1>(v); v += swz_xor<2>(v); v += swz_xor<4>(v); v += swz_xor<8>(v); v += swz_xor<16>(v); return sum_x32(v); }
__device__ __forceinline__ float wave_max(float v) { v = fmaxf(v, swz_xor<1>(v)); v = fmaxf(v, swz_xor<2>(v)); v = fmaxf(v, swz_xor<4>(v)); v = fmaxf(v, swz_xor<8>(v)); v = fmaxf(v, swz_xor<16>(v)); return max_x32(v); }
__device__ __forceinline__ int opaque_tid(int wv) { int t; asm volatile("v_mbcnt_lo_u32_b32 %0, -1, 0\n\tv_mbcnt_hi_u32_b32 %0, -1, %0" : "=v"(t)); return wv * 64 + t; }
__device__ __forceinline__ float sigmoidf_(float v) { return 1.0f / (1.0f + __expf(-v)); }

__device__ __forceinline__ int t5_bucket(int rel) {
    const int n = rel < 0 ? -rel : rel; const int ret = rel > 0 ? 16 : 0;
    if (n < 8) return ret + n;
    int l = 8; l += (n >= 15); l += (n >= 27); l += (n >= 50); l += (n >= 91); l += (n >= 166); l += (n >= 305); l += (n >= 559);
    return ret + l;
}

__device__ __forceinline__ void ph_norm_rows(const float* src, const float* gain, bf16_t* dst, int vcu, int nb, int wv) {
    const int tid = opaque_tid(wv);
    const int lane = tid & 63, wave = tid >> 6;
    const int gw = vcu * NWAVES + wave, ngw = nb * NWAVES;
    f32x4 gn[4];
#pragma unroll
    for (int j = 0; j < 4; ++j) gn[j] = ((const f32x4*)gain)[lane + 64 * j];
    for (int m0 = gw * 4; m0 < T; m0 += ngw * 4) {
        f32x4 v[4][4];
#pragma unroll
        for (int q = 0; q < 4; ++q)
#pragma unroll
            for (int j = 0; j < 4; ++j) v[q][j] = ((const f32x4*)(src + (size_t)(m0 + q) * D))[lane + 64 * j];
#pragma unroll
        for (int q = 0; q < 4; ++q) {
            float s = 0.f;
#pragma unroll
            for (int j = 0; j < 4; ++j) s += (v[q][j].x * v[q][j].x + v[q][j].y * v[q][j].y) + (v[q][j].z * v[q][j].z + v[q][j].w * v[q][j].w);
            const float r = rsqrtf(wave_sum(s) * (1.f / D) + EPS);
            u32x2* o8 = (u32x2*)(dst + (size_t)(m0 + q) * D) + lane;
#pragma unroll
            for (int j = 0; j < 4; ++j) { u32x2 w; w.x = pk2(v[q][j].x * r * gn[j].x, v[q][j].y * r * gn[j].y); w.y = pk2(v[q][j].z * r * gn[j].z, v[q][j].w * r * gn[j].w); o8[64 * j] = w; }
        }
    }
}


__device__ __forceinline__ void ph_x_to_h(const float* src, bf16_t* dst, float* rs, int vcu, int nb, int wv) {
    const int tid = opaque_tid(wv);
    const int lane = tid & 63, wave = tid >> 6;
    const int gw = vcu * NWAVES + wave, ngw = nb * NWAVES;
    for (int m0 = gw * 4; m0 < T; m0 += ngw * 4) {
        f32x4 v[4][4];
#pragma unroll
        for (int q = 0; q < 4; ++q)
#pragma unroll
            for (int j = 0; j < 4; ++j) v[q][j] = ((const f32x4*)(src + (size_t)(m0 + q) * D))[lane + 64 * j];
#pragma unroll
        for (int q = 0; q < 4; ++q) {
            float s = 0.f;
#pragma unroll
            for (int j = 0; j < 4; ++j) s += (v[q][j].x * v[q][j].x + v[q][j].y * v[q][j].y) + (v[q][j].z * v[q][j].z + v[q][j].w * v[q][j].w);
            const float r = rsqrtf(wave_sum(s) * (1.f / D) + EPS);
            if (lane == 0) rs[m0 + q] = r;
            u32x2* o8 = (u32x2*)(dst + (size_t)(m0 + q) * D) + lane;
#pragma unroll
            for (int j = 0; j < 4; ++j) { u32x2 w; w.x = pk2(v[q][j].x, v[q][j].y); w.y = pk2(v[q][j].z, v[q][j].w); o8[64 * j] = w; }
        }
    }
}

__device__ __forceinline__ void ph_fold_wpc(const Ctx& c, int vcu, int nb, int wv) {
    const int tid = opaque_tid(wv);
    const int lane = tid & 63, wave = __builtin_amdgcn_readfirstlane(tid >> 6);
    const int gw = vcu * NWAVES + wave, ngw = nb * NWAVES;
    for (int it = gw; it < DEPTH * 4 * 16 * 16; it += ngw) {
        const int cc = it & 15, nbk = (it >> 4) & 15, g = (it >> 8) & 3, l = it >> 10;
        const int n = nbk * 64 + lane, c0 = cc * 8;
        const float* pw = c.pool_w + ((size_t)(l * 4 + g) * PGW + c0) * PGW;
        const float* ps = c.pool_scale + (size_t)l * PW + g * PGW;
        const float* wp = c.w_proj_pool + ((size_t)l * PW + g * PGW) * D + n;
        float acc[8];
#pragma unroll
        for (int i = 0; i < 8; ++i) acc[i] = 0.f;
#pragma unroll 2
        for (int e0 = 0; e0 < PGW; e0 += 8) {
            float w[8];
            const f32x4 s0 = *(const f32x4*)(ps + e0), s1 = *(const f32x4*)(ps + e0 + 4);
#pragma unroll
            for (int q = 0; q < 8; ++q) w[q] = wp[(size_t)(e0 + q) * D] * (q < 4 ? s0[q] : s1[q - 4]);
#pragma unroll
            for (int i = 0; i < 8; ++i) { const f32x4 a = *(const f32x4*)(pw + i * PGW + e0), b = *(const f32x4*)(pw + i * PGW + e0 + 4);
                acc[i] += (a.x * w[0] + a.y * w[1]) + (a.z * w[2] + a.w * w[3]) + (b.x * w[4] + b.y * w[5]) + (b.z * w[6] + b.w * w[7]); }
        }
        u32x4 w0; w0.x = pk2(acc[0], acc[1]); w0.y = pk2(acc[2], acc[3]); w0.z = pk2(acc[4], acc[5]); w0.w = pk2(acc[6], acc[7]);
        *(u32x4*)(c.WP() + ((size_t)l * D + n) * A2W + AOW + g * PGW + c0) = w0;
    }
}

typedef short bf16x8_r __attribute__((ext_vector_type(8)));
__device__ __forceinline__ void split8(const f32x4& x0, const f32x4& x1, bf16x8_r& hi, bf16x8_r& lo) {
    u32x4 h, l;
    const unsigned h0 = f2bf(x0.x), h1 = f2bf(x0.y), h2 = f2bf(x0.z), h3 = f2bf(x0.w), h4 = f2bf(x1.x), h5 = f2bf(x1.y), h6 = f2bf(x1.z), h7 = f2bf(x1.w);
    h.x = h0 | (h1 << 16); h.y = h2 | (h3 << 16); h.z = h4 | (h5 << 16); h.w = h6 | (h7 << 16);
    l.x = pk2(x0.x - __uint_as_float(h0 << 16), x0.y - __uint_as_float(h1 << 16)); l.y = pk2(x0.z - __uint_as_float(h2 << 16), x0.w - __uint_as_float(h3 << 16));
    l.z = pk2(x1.x - __uint_as_float(h4 << 16), x1.y - __uint_as_float(h5 << 16)); l.w = pk2(x1.z - __uint_as_float(h6 << 16), x1.w - __uint_as_float(h7 << 16));
    hi = __builtin_bit_cast(bf16x8_r, h); lo = __builtin_bit_cast(bf16x8_r, l);
}
constexpr int WR_FRAGS = 32 * 5 * 64;
__device__ __forceinline__ void ph_router(const Ctx& c, int layer, int vcu, int nb, LAS unsigned char* lds, int wv) {
    const int tid = opaque_tid(wv);
    const int lane = tid & 63, wave = __builtin_amdgcn_readfirstlane(tid >> 6), g = lane >> 4, cq = lane & 15;
    LAS float* slab = (LAS float*)lds;
    LAS float* lss = slab + 4 * 64 * 80;
    LAS int* lhist = (LAS int*)(lss + 256);
    const int t0 = vcu * 64;
    const bf16x8_r* WRh = (const bf16x8_r*)c.WR() + (size_t)layer * 2 * WR_FRAGS; const bf16x8_r* WRl = WRh + WR_FRAGS;
    f32x4 acc[4][5]; float ss[4] = {0.f, 0.f, 0.f, 0.f};
#pragma unroll
    for (int mi = 0; mi < 4; ++mi)
#pragma unroll
        for (int nt = 0; nt < 5; ++nt) acc[mi][nt] = (f32x4){0.f, 0.f, 0.f, 0.f};
    if (tid < NE) lhist[tid] = 0;
#pragma unroll
    for (int ks = 0; ks < 4; ++ks) {
        const int kk = 4 * wave + ks;
        bf16x8_r bh[5], bl[5];
#pragma unroll
        for (int nt = 0; nt < 5; ++nt) { bh[nt] = WRh[(kk * 5 + nt) * 64 + lane]; bl[nt] = WRl[(kk * 5 + nt) * 64 + lane]; }
#pragma unroll
        for (int mi = 0; mi < 4; ++mi) {
            const u32x4 hx = *(const u32x4*)(c.H() + (size_t)(t0 + 16 * mi + cq) * D + 32 * kk + 8 * g);
            f32x4 x0, x1;
            x0.x = __uint_as_float(hx.x << 16); x0.y = __uint_as_float(hx.x & 0xffff0000u); x0.z = __uint_as_float(hx.y << 16); x0.w = __uint_as_float(hx.y & 0xffff0000u);
            x1.x = __uint_as_float(hx.z << 16); x1.y = __uint_as_float(hx.z & 0xffff0000u); x1.z = __uint_as_float(hx.w << 16); x1.w = __uint_as_float(hx.w & 0xffff0000u);
            ss[mi] += (x0.x * x0.x + x0.y * x0.y) + (x0.z * x0.z + x0.w * x0.w) + (x1.x * x1.x + x1.y * x1.y) + (x1.z * x1.z + x1.w * x1.w);
            const bf16x8_r ah = __builtin_bit_cast(bf16x8_r, hx);
#pragma unroll
            for (int nt = 0; nt < 5; ++nt) {
                acc[mi][nt] = __builtin_amdgcn_mfma_f32_16x16x32_bf16(ah, bh[nt], acc[mi][nt], 0, 0, 0);
                acc[mi][nt] = __builtin_amdgcn_mfma_f32_16x16x32_bf16(ah, bl[nt], acc[mi][nt], 0, 0, 0);
            }
        }
    }
    LAS float* myslab = slab + (wave & 3) * 64 * 80;
#pragma unroll
    for (int mi = 0; mi < 4; ++mi) { float sv = ss[mi]; sv += swz_xor<16>(sv); ss[mi] = sum_x32(sv); }
    if (wave < 4) {
#pragma unroll
        for (int mi = 0; mi < 4; ++mi) {
#pragma unroll
            for (int nt = 0; nt < 5; ++nt)
#pragma unroll
                for (int j = 0; j < 4; ++j) myslab[(16 * mi + 4 * g + j) * 80 + 16 * nt + cq] = acc[mi][nt][j];
            if (g == 0) lss[(wave & 3) * 64 + 16 * mi + cq] = ss[mi];
        }
    }
    __syncthreads();
    if (wave >= 4) {
#pragma unroll
        for (int mi = 0; mi < 4; ++mi) {
#pragma unroll
            for (int nt = 0; nt < 5; ++nt)
#pragma unroll
                for (int j = 0; j < 4; ++j) myslab[(16 * mi + 4 * g + j) * 80 + 16 * nt + cq] += acc[mi][nt][j];
            if (g == 0) lss[(wave & 3) * 64 + 16 * mi + cq] += ss[mi];
        }
    }
    __syncthreads();
    if (tid < 64) {
        const int t = t0 + tid;
        const float r = rsqrtf(((lss[tid] + lss[64 + tid]) + (lss[128 + tid] + lss[192 + tid])) * (1.f / D) + EPS);
        LAS const float* s0 = slab + tid * 80;
        float a[8];
#pragma unroll
        for (int q = 0; q < 8; ++q) a[q] = ((s0[q] + s0[5120 + q]) + (s0[10240 + q] + s0[15360 + q])) * r;
        int gi = 0; float lmax = a[0];
#pragma unroll
        for (int q = 1; q < 8; ++q) if (a[q] > lmax) { lmax = a[q]; gi = q; }
        float se = 0.f;
#pragma unroll
        for (int q = 0; q < 8; ++q) se += __expf(a[q] - lmax);
        const float gp = 1.0f / se;
        float bq[8];
#pragma unroll
        for (int q = 0; q < 8; ++q) { const int n = 8 + gi * 8 + q; bq[q] = ((s0[n] + s0[5120 + n]) + (s0[10240 + n] + s0[15360 + n])) * r; }
        int i0 = 0; float v0 = bq[0];
#pragma unroll
        for (int q = 1; q < 8; ++q) if (bq[q] > v0) { v0 = bq[q]; i0 = q; }
        int i1 = -1; float v1 = -3.0e38f;
#pragma unroll
        for (int q = 0; q < 8; ++q) if (q != i0 && bq[q] > v1) { v1 = bq[q]; i1 = q; }
        const float e1 = __expf(v1 - v0), p0 = 1.0f / (1.0f + e1), p1 = e1 * p0;
        const int ea = gi * EPG + i0, eb = gi * EPG + i1;
        c.EID()[2 * t] = ea; c.EID()[2 * t + 1] = eb;
        c.CW()[2 * t] = gp * p0; c.CW()[2 * t + 1] = gp * p1;
        c.RSTD()[t] = r;
        __hip_atomic_fetch_add(&lhist[ea], 1, __ATOMIC_RELAXED, __HIP_MEMORY_SCOPE_WORKGROUP); __hip_atomic_fetch_add(&lhist[eb], 1, __ATOMIC_RELAXED, __HIP_MEMORY_SCOPE_WORKGROUP);
    }
    __syncthreads();
    if (tid < NE) c.HIST()[vcu * NE + tid] = lhist[tid];
    for (int i = vcu * NTHR + tid; i < PMAX; i += nb * NTHR) c.SRC()[i] = 0;
}


__device__ __forceinline__ void ph_scatter(const Ctx& c, int layer, int vcu, int nb, LAS int* lds, int wv) {
    const int tid = opaque_tid(wv);
    const int lane = tid & 63, wave = tid >> 6;
    const int TPB = T / nb, NA = 2 * TPB;
    LAS int* l_cnt = lds; LAS int* l_base = lds + 64; LAS int* l_poff = lds + 128; LAS int* l_eid = lds + 192; LAS int* l_dest = lds + 192 + NA; LAS int* l_pt = lds + 192 + 2 * NA; LAS int* l_pb = l_pt + 512;
    {
        const int e = tid & 63, part = tid >> 6, bper = nb / 8;
        int tot = 0, base = 0;
#pragma unroll 8
        for (int i = 0; i < bper; ++i) { const int b = part * bper + i; const int hv = c.HIST()[b * NE + e]; tot += hv; base += (b < vcu) ? hv : 0; }
        l_pt[part * 64 + e] = tot; l_pb[part * 64 + e] = base;
    }
    for (int a = tid; a < NA; a += NTHR) l_eid[a] = c.EID()[vcu * NA + a];
    __syncthreads();
    int my_nt = 0;
    if (tid < NE) { int tot = 0, base = 0;
#pragma unroll
        for (int p = 0; p < 8; ++p) { tot += l_pt[p * 64 + tid]; base += l_pb[p * 64 + tid]; }
        my_nt = (tot + PTILE - 1) / PTILE;
        l_cnt[tid] = my_nt; l_base[tid] = base; l_pt[tid] = 0; }
    __syncthreads();
    if (tid < NE) {
        int off = 0;
#pragma unroll
        for (int e = 0; e < NE; ++e) { const int v = l_cnt[e]; off += (e < tid) ? v : 0; }
        l_poff[tid] = off * PTILE;
        if (vcu == 0) { for (int i = 0; i < my_nt; ++i) c.TILEE()[off + i] = tid; if (tid == NE - 1) c.META()[0] = off + my_nt; }
    }
    __syncthreads();
    for (int a = tid; a < NA; a += NTHR) {
        const int e = l_eid[a];
        const int rank = __hip_atomic_fetch_add(&l_pt[e], 1, __ATOMIC_RELAXED, __HIP_MEMORY_SCOPE_WORKGROUP);
        const int dst = l_poff[e] + l_base[e] + rank;
        l_dest[a] = dst; c.DEST()[vcu * NA + a] = dst;
    }
    __syncthreads();
    for (int a = tid; a < NA; a += NTHR) { const int t = vcu * TPB + (a >> 1); c.SRC()[l_dest[a]] = t; c.RS()[l_dest[a]] = c.RSTD()[t]; }
}

__device__ __forceinline__ void ph_combine(const Ctx& c, int layer, int vcu, int nb, int wv) {
    const int tid = opaque_tid(wv);
    const int lane = tid & 63, wave = tid >> 6;
    const int gw = vcu * NWAVES + wave, ngw = nb * NWAVES;
    const bool last = (layer == DEPTH - 1);
    const float* gain = last ? c.norm_final_g : c.norm_mix_g + (size_t)(layer + 1) * D;
    f32x4 gn[4];
#pragma unroll
    for (int j = 0; j < 4; ++j) gn[j] = ((const f32x4*)gain)[lane + 64 * j];
    const int tpb = T / nb;
    for (int t0 = vcu * tpb + wave * 4; t0 < (vcu + 1) * tpb; t0 += NWAVES * 4) {
        int d0[4], d1[4]; float w0[4], w1[4];
#pragma unroll
        for (int q = 0; q < 4; ++q) { d0[q] = c.DEST()[2 * (t0 + q)]; d1[q] = c.DEST()[2 * (t0 + q) + 1]; w0[q] = c.CW()[2 * (t0 + q)]; w1[q] = c.CW()[2 * (t0 + q) + 1]; }
        f32x4 h[4][4]; u32x2 ya[4][4], yb[4][4];
#pragma unroll
        for (int q = 0; q < 4; ++q)
#pragma unroll
            for (int j = 0; j < 4; ++j) {
                { const u32x2 hv = ((const u32x2*)(c.H() + (size_t)(t0 + q) * D))[lane + 64 * j];
                  h[q][j].x = __uint_as_float(hv.x << 16); h[q][j].y = __uint_as_float(hv.x & 0xffff0000u); h[q][j].z = __uint_as_float(hv.y << 16); h[q][j].w = __uint_as_float(hv.y & 0xffff0000u); }
                ya[q][j] = ((const u32x2*)(c.YPAD() + (size_t)d0[q] * D))[lane + 64 * j];
                yb[q][j] = ((const u32x2*)(c.YPAD() + (size_t)d1[q] * D))[lane + 64 * j];
            }
#pragma unroll
        for (int q = 0; q < 4; ++q) {
            float s = 0.f;
#pragma unroll
            for (int j = 0; j < 4; ++j) {
                const u32x2 a = ya[q][j], b = yb[q][j]; f32x4 o = h[q][j];
                o.x += w0[q] * __uint_as_float(a.x << 16) + w1[q] * __uint_as_float(b.x << 16);
                o.y += w0[q] * __uint_as_float(a.x & 0xffff0000u) + w1[q] * __uint_as_float(b.x & 0xffff0000u);
                o.z += w0[q] * __uint_as_float(a.y << 16) + w1[q] * __uint_as_float(b.y << 16);
                o.w += w0[q] * __uint_as_float(a.y & 0xffff0000u) + w1[q] * __uint_as_float(b.y & 0xffff0000u);
                h[q][j] = o; s += (o.x * o.x + o.y * o.y) + (o.z * o.z + o.w * o.w);
            }
            const float r = rsqrtf(wave_sum(s) * (1.f / D) + EPS);
            if (!last) {
                u32x2* hw = (u32x2*)(c.H() + (size_t)(t0 + q) * D) + lane;
#pragma unroll
                for (int j = 0; j < 4; ++j) { u32x2 hv; hv.x = pk2(h[q][j].x, h[q][j].y); hv.y = pk2(h[q][j].z, h[q][j].w); hw[64 * j] = hv; }
                if (lane == 0) c.RSTDM()[t0 + q] = r;
            } else {
                f32x4* o = (f32x4*)(c.out + (size_t)(t0 + q) * D) + lane;
#pragma unroll
                for (int j = 0; j < 4; ++j) { f32x4 w; w.x = h[q][j].x * r * gn[j].x; w.y = h[q][j].y * r * gn[j].y; w.z = h[q][j].z * r * gn[j].z; w.w = h[q][j].w * r * gn[j].w; o[64 * j] = w; }
            }
        }
    }
}


__device__ __forceinline__ void unpack8(const u32x4 w, float (&f)[8]) {
    f[0] = __uint_as_float(w.x << 16); f[1] = __uint_as_float(w.x & 0xffff0000u); f[2] = __uint_as_float(w.y << 16); f[3] = __uint_as_float(w.y & 0xffff0000u);
    f[4] = __uint_as_float(w.z << 16); f[5] = __uint_as_float(w.z & 0xffff0000u); f[6] = __uint_as_float(w.w << 16); f[7] = __uint_as_float(w.w & 0xffff0000u);
}
__device__ __forceinline__ void ph_pool(const Ctx& c, int vcu, int nb, LAS unsigned char* lds, int wv) {
    const int tid = opaque_tid(wv);
    const bf16_t* P = c.PROJ();
    const int cg = tid & 63, tq = tid >> 6, hw = 1 << (cg >> 4);
    for (int tile = vcu; tile < T / 64; tile += nb) {
        const int t0 = tile * 64, b = t0 / SEQ, i0 = t0 % SEQ;
        __syncthreads();
#pragma unroll
        for (int k = 0; k < 10; ++k) {
            const int idx = tid + NTHR * k, row = idx >> 6, ch = idx & 63, pos = i0 - 8 + row;
            u32x4 v = {0u, 0u, 0u, 0u};
            if (pos >= 0 && pos < SEQ) v = *(const u32x4*)(P + (size_t)(b * SEQ + pos) * NIN + COL_U + ch * 8);
            *(LAS u32x4*)(lds + row * 1024 + ch * 16) = v;
        }
        __syncthreads();
        LAS const unsigned char* col = lds + cg * 16;
        const int r0 = 8 * tq + 8;
        float S[8], f[8];
#pragma unroll
        for (int e = 0; e < 8; ++e) S[e] = 0.f;
#pragma unroll
        for (int q = 0; q < 16; ++q) {
            unpack8(*(LAS const u32x4*)(col + (r0 - hw + q) * 1024), f);
            const float on = (q < 2 * hw) ? 1.f : 0.f;
#pragma unroll
            for (int e = 0; e < 8; ++e) S[e] += on * f[e];
        }
        bf16_t* outp = c.A2() + (size_t)(t0 + 8 * tq) * A2W + AOW + 8 * cg;
#pragma unroll
        for (int jt = 0; jt < 8; ++jt) {
            const int pos = i0 + 8 * tq + jt, lo = max(pos - hw, 0), hi = min(pos + hw, SEQ);
            const float inv = 1.0f / (float)(hi - lo);
            unpack8(*(LAS const u32x4*)(col + (r0 + jt) * 1024), f);
            u32x4 w; w.x = pk2(S[0] * inv - f[0], S[1] * inv - f[1]); w.y = pk2(S[2] * inv - f[2], S[3] * inv - f[3]); w.z = pk2(S[4] * inv - f[4], S[5] * inv - f[5]); w.w = pk2(S[6] * inv - f[6], S[7] * inv - f[7]);
            *(u32x4*)(outp + (size_t)jt * A2W) = w;
            if (jt < 7) {
                float a[8], d[8]; unpack8(*(LAS const u32x4*)(col + (r0 + jt + hw) * 1024), a); unpack8(*(LAS const u32x4*)(col + (r0 + jt - hw) * 1024), d);
#pragma unroll
                for (int e = 0; e < 8; ++e) S[e] += a[e] - d[e];
            }
        }
    }
}

typedef short bf16x8_t __attribute__((ext_vector_type(8)));
typedef short s16x4_t __attribute__((ext_vector_type(4)));
constexpr int AT_ROWB = 160;
constexpr int AT_KOFF = 0, AT_VOFF = 192 * AT_ROWB, AT_BIAS = 2 * 192 * AT_ROWB, AT_SLOT = AT_BIAS + 1024;
constexpr int NUNITS = NB_ * 3 * HPG * 32;
static_assert(2 * AT_SLOT <= 131072, "attention LDS");
__device__ __forceinline__ s16x4_t lds_tr16(LAS const unsigned char* p) { return __builtin_bit_cast(s16x4_t, __builtin_amdgcn_ds_read_tr16_b64_v4i16((LAS s16x4_t*)p)); }

struct AttnUnit { size_t tok0; int dil, L, blk, nblk, gi, hh, head; };
__device__ __forceinline__ AttnUnit attn_decode(int u) {
    AttnUnit a; const int b = u / 384, rem = u % 384; a.gi = rem >> 7; a.hh = (rem >> 5) & 3; const int rb = rem & 31;
    const int dsh = 2 * a.gi; a.dil = 1 << dsh; a.L = SEQ >> dsh; a.nblk = a.L >> 6;
    const int r = rb / a.nblk; a.blk = rb % a.nblk; a.head = a.gi * HPG + a.hh; a.tok0 = (size_t)b * SEQ + r; return a;
}
__device__ __forceinline__ void ph_attention(const Ctx& c, int vcu, int nb, LAS unsigned char* lds, int wv) {
    const int tid = opaque_tid(wv);
    const int wave = __builtin_amdgcn_readfirstlane(tid >> 6), lane = tid & 63, half = wave >> 2, wq = wave & 3, ht = tid & 255;
    const int g = lane >> 4, cq = lane & 15;
    LAS unsigned char* slot = lds + half * AT_SLOT;
    LAS float* lbias = (LAS float*)(slot + AT_BIAS);
    const bf16_t* P = c.PROJ();
    constexpr float LOG2E = 1.4426950408889634f, QSC = 0.125f * LOG2E;
    u32x4 rk[6], rv[6]; bf16x8_t rq0, rq1; float rb = 0.f;
    AttnUnit un = attn_decode(0);
    auto issue = [&](const AttnUnit& a) {
#pragma unroll
        for (int i = 0; i < 6; ++i) {
            const int idx = ht + 256 * i, row = idx >> 3, ch = idx & 7, lk = 64 * a.blk - 64 + row;
            rk[i] = (u32x4){0u, 0u, 0u, 0u}; rv[i] = (u32x4){0u, 0u, 0u, 0u};
            if (lk >= 0 && lk < a.L) { const bf16_t* rp = P + (a.tok0 + (size_t)a.dil * lk) * NIN + a.head * HD + ch * 8; rk[i] = *(const u32x4*)(rp + COL_K); rv[i] = *(const u32x4*)(rp + COL_V); }
        }
        { const bf16_t* qp = P + (a.tok0 + (size_t)a.dil * (64 * a.blk + 16 * wq + cq)) * NIN + a.head * HD + 8 * g; rq0 = *(const bf16x8_t*)qp; rq1 = *(const bf16x8_t*)(qp + 32); }
        if (ht < 160) { const int rel = ht - 80; rb = (rel >= -64 && rel <= 64) ? c.rel_bias[t5_bucket(a.dil * rel) * NH + a.head] * LOG2E : -1e30f; }
    };
    const bool bl_ = (nb == 256);
    auto pair_of = [&](int it) -> int { return bl_ ? ((it < 6) ? (vcu >> 5) * 192 + it * 32 + (vcu & 31) : NUNITS) : it * nb + vcu; };
    if (pair_of(0) * 2 < NUNITS) { un = attn_decode(pair_of(0) * 2 + half); issue(un); }
    for (int it = 0;; ++it) {
        const int pair = pair_of(it);
        if (pair * 2 >= NUNITS) break;
        const AttnUnit a = un;
#pragma unroll
        for (int i = 0; i < 6; ++i) {
            const int idx = ht + 256 * i, row = idx >> 3, ch = idx & 7;
            *(LAS u32x4*)(slot + AT_KOFF + row * AT_ROWB + ch * 16) = rk[i];
            *(LAS u32x4*)(slot + AT_VOFF + row * AT_ROWB + ch * 16) = rv[i];
        }
        if (ht < 160) lbias[ht] = rb;
        const bf16x8_t qf0 = rq0, qf1 = rq1;
        __syncthreads();
        { const int np = pair_of(it + 1); if (np * 2 < NUNITS) { un = attn_decode(np * 2 + half); issue(un); } }
        f32x4 sc[9];
#pragma unroll
        for (int t = 0; t < 9; ++t) {
            LAS const unsigned char* kp = slot + AT_KOFF + (16 * (wq + t) + cq) * AT_ROWB + 16 * g;
            const bf16x8_t a0 = *(LAS const bf16x8_t*)kp, a1 = *(LAS const bf16x8_t*)(kp + 64);
            f32x4 z = {0.f, 0.f, 0.f, 0.f};
            z = __builtin_amdgcn_mfma_f32_16x16x32_bf16(a0, qf0, z, 0, 0, 0);
            sc[t] = __builtin_amdgcn_mfma_f32_16x16x32_bf16(a1, qf1, z, 0, 0, 0);
        }
        LAS const float* bl = lbias + (16 + 4 * g - cq);
        float m = -1e30f;
#pragma unroll
        for (int t = 0; t < 9; ++t) {
            const bool dead = (a.blk == 0 && wq + t < 4) || (a.blk == a.nblk - 1 && wq + t >= 8);
#pragma unroll
            for (int j = 0; j < 4; ++j) { float v = sc[t][j] * QSC + bl[16 * t + j]; v = dead ? -1e30f : v; sc[t][j] = v; m = fmaxf(m, v); }
        }
        m = fmaxf(m, swz_xor<16>(m)); m = max_x32(m);
        float den = 0.f;
#pragma unroll
        for (int t = 0; t < 9; ++t)
#pragma unroll
            for (int j = 0; j < 4; ++j) { const float p = __builtin_amdgcn_exp2f(sc[t][j] - m); sc[t][j] = p; den += p; }
        den += swz_xor<16>(den); den = sum_x32(den);
        f32x4 o[4];
#pragma unroll
        for (int dt = 0; dt < 4; ++dt) o[dt] = (f32x4){0.f, 0.f, 0.f, 0.f};
#pragma unroll
        for (int ks = 0; ks < 5; ++ks) {
            const int t0 = 2 * ks, t1 = (2 * ks + 1 < 9) ? 2 * ks + 1 : 2 * ks;
            u32x4 pw;
            pw.x = pk2(sc[t0][0], sc[t0][1]); pw.y = pk2(sc[t0][2], sc[t0][3]);
            if (2 * ks + 1 < 9) { pw.z = pk2(sc[t1][0], sc[t1][1]); pw.w = pk2(sc[t1][2], sc[t1][3]); } else { pw.z = 0u; pw.w = 0u; }
            const bf16x8_t pa = __builtin_bit_cast(bf16x8_t, pw);
            LAS const unsigned char* v0 = slot + AT_VOFF + (16 * (wq + t0) + 4 * g + (cq >> 2)) * AT_ROWB + 8 * (cq & 3);
            LAS const unsigned char* v1 = slot + AT_VOFF + (16 * (wq + t1) + 4 * g + (cq >> 2)) * AT_ROWB + 8 * (cq & 3);
#pragma unroll
            for (int dt = 0; dt < 4; ++dt) {
                const s16x4_t b0 = lds_tr16(v0 + 32 * dt), b1 = lds_tr16(v1 + 32 * dt);
                const bf16x8_t bb = __builtin_shufflevector(b0, b1, 0, 1, 2, 3, 4, 5, 6, 7);
                o[dt] = __builtin_amdgcn_mfma_f32_16x16x32_bf16(pa, bb, o[dt], 0, 0, 0);
            }
        }
        bf16_t* og = c.OG() + (size_t)a.gi * T * AOW;
        const int lq0 = 64 * a.blk + 16 * wq;
#pragma unroll
        for (int j = 0; j < 4; ++j) {
            const float inv = __builtin_amdgcn_rcpf(__int_as_float(__builtin_amdgcn_ds_bpermute((4 * g + j) << 2, __float_as_int(den))));
            bf16_t* op = og + (a.tok0 + (size_t)a.dil * (lq0 + 4 * g + j)) * AOW + a.hh * HD + cq;
            const unsigned w01 = pk2(o[0][j] * inv, o[1][j] * inv), w23 = pk2(o[2][j] * inv, o[3][j] * inv);
            op[0] = (bf16_t)(w01 & 0xffffu); op[16] = (bf16_t)(w01 >> 16); op[32] = (bf16_t)(w23 & 0xffffu); op[48] = (bf16_t)(w23 >> 16);
        }
        if (g == 0) c.LSE()[((size_t)a.gi * T + a.tok0 + (size_t)a.dil * (lq0 + cq)) * HPG + a.hh] = (m + __builtin_amdgcn_logf(den)) * 0.6931471805599453f;
        __syncthreads();
    }
}
__device__ __forceinline__ void ph_merge64(const Ctx& c, int t_lo, int wv) {
    const int tid = opaque_tid(wv);
    const unsigned long long ab_u = (unsigned long long)(uintptr_t)c.A2();
    const unsigned ab_lo = (unsigned)__builtin_amdgcn_readfirstlane((unsigned)ab_u), ab_hi = (unsigned)__builtin_amdgcn_readfirstlane((unsigned)(ab_u >> 32));
    const __amdgpu_buffer_rsrc_t ars = __builtin_amdgcn_make_buffer_rsrc((void*)(uintptr_t)(((unsigned long long)ab_hi << 32) | ab_lo), (short)0, (int)((size_t)T * A2W * 2), 0x00020000);
#pragma unroll
    for (int it = 0; it < 4; ++it) {
        const int idx = it * NTHR + tid;
        const int t = t_lo + (idx >> 5), ch = idx & 31, hh = ch >> 3;
        const float l0 = c.LSE()[((size_t)0 * T + t) * HPG + hh], l1 = c.LSE()[((size_t)1 * T + t) * HPG + hh], l2 = c.LSE()[((size_t)2 * T + t) * HPG + hh];
        const float mm = fmaxf(fmaxf(l0, l1), l2);
        float e0 = __expf(l0 - mm), e1 = __expf(l1 - mm), e2 = __expf(l2 - mm);
        const float inv = 1.0f / (e0 + e1 + e2); e0 *= inv; e1 *= inv; e2 *= inv;
        const u32x4 a = *(const u32x4*)(c.OG() + ((size_t)0 * T + t) * AOW + ch * 8), b = *(const u32x4*)(c.OG() + ((size_t)1 * T + t) * AOW + ch * 8), d = *(const u32x4*)(c.OG() + ((size_t)2 * T + t) * AOW + ch * 8);
        u32x4 w;
        w.x = pk2(e0 * __uint_as_float(a.x << 16) + e1 * __uint_as_float(b.x << 16) + e2 * __uint_as_float(d.x << 16), e0 * __uint_as_float(a.x & 0xffff0000u) + e1 * __uint_as_float(b.x & 0xffff0000u) + e2 * __uint_as_float(d.x & 0xffff0000u));
        w.y = pk2(e0 * __uint_as_float(a.y << 16) + e1 * __uint_as_float(b.y << 16) + e2 * __uint_as_float(d.y << 16), e0 * __uint_as_float(a.y & 0xffff0000u) + e1 * __uint_as_float(b.y & 0xffff0000u) + e2 * __uint_as_float(d.y & 0xffff0000u));
        w.z = pk2(e0 * __uint_as_float(a.z << 16) + e1 * __uint_as_float(b.z << 16) + e2 * __uint_as_float(d.z << 16), e0 * __uint_as_float(a.z & 0xffff0000u) + e1 * __uint_as_float(b.z & 0xffff0000u) + e2 * __uint_as_float(d.z & 0xffff0000u));
        w.w = pk2(e0 * __uint_as_float(a.w << 16) + e1 * __uint_as_float(b.w << 16) + e2 * __uint_as_float(d.w << 16), e0 * __uint_as_float(a.w & 0xffff0000u) + e1 * __uint_as_float(b.w & 0xffff0000u) + e2 * __uint_as_float(d.w & 0xffff0000u));
        __builtin_amdgcn_raw_buffer_store_b128(w, ars, (int)(((unsigned)t * A2W + ch * 8) * 2u), 0, 16);
    }
}

namespace pg8 {
#define PG8_LAS __attribute__((address_space(3)))
typedef unsigned short bf16_t;
typedef short bf16x8 __attribute__((ext_vector_type(8)));
typedef float f32x4 __attribute__((ext_vector_type(4)));
typedef unsigned u32x4 __attribute__((ext_vector_type(4)));
constexpr int BM = 256, BK = 64, HALF = 128, HTB = HALF * BK * 2  , STAGE_BYTES = 8 * HTB, NXCD = 8, WGM = 8;

__host__ __device__ __forceinline__ int lds_byte(int r, int c) { const int st = (r >> 4) * 2 + (c >> 5), rr = r & 15, cc = c & 31, ob = rr * 64 + cc * 2; return st * 1024 + (ob ^ (((ob >> 9) & 1) << 5)); }
__host__ __device__ __forceinline__ void stage_rc(int b, int& R, int& C) { const int st = b / 1024, sb = b % 1024, swz = sb ^ (((sb >> 9) & 1) << 5); R = (st >> 1) * 16 + swz / 64; C = (st & 1) * 32 + (swz % 64) / 2; }
__host__ __device__ __forceinline__ int perm32(int rho) { const int n = rho >> 4, i = rho & 15; return 8 * (i >> 2) + 4 * n + (i & 3); }

struct Unit { int pm, pn, pb; };
struct Gemm { const bf16_t* A; const bf16_t* Bt; int M, N, K; };

struct StaticOrder {
    int nM, nN, nwg, G, c;
    __host__ __device__ void init(int M, int N, int G_, int c_) { nM = M / BM; nN = N / BM; nwg = nM * nN; G = G_; c = c_; }
    __host__ __device__ bool next(int i, Unit& u) const {
        const long L = (long)i * G + c; if (L >= nwg) return false;
        int wgid = (int)L; { const int q = nwg / NXCD, r = nwg % NXCD, xcd = wgid % NXCD, off = wgid / NXCD; wgid = (xcd < r ? xcd * (q + 1) : r * (q + 1) + (xcd - r) * q) + off; }
        const int nig = WGM * nN, gid = wgid / nig, fm = gid * WGM, gsz = (nM - fm) < WGM ? (nM - fm) : WGM;
        u.pm = fm + ((wgid % nig) % gsz); u.pn = (wgid % nig) / gsz; u.pb = u.pn; return true;
    }
    __device__ __forceinline__ void a_ready(const Unit&) const {}
    __device__ __forceinline__ void done(const Unit&) const {}
};


__device__ __forceinline__ unsigned cvt_pk_bf16(float lo, float hi) { unsigned r; asm volatile("v_cvt_pk_bf16_f32 %0, %1, %2" : "=v"(r) : "v"(lo), "v"(hi)); return r; }
__device__ __forceinline__ float bflo(unsigned w) { return __uint_as_float(w << 16); }
__device__ __forceinline__ float bfhi(unsigned w) { return __uint_as_float(w & 0xffff0000u); }
__device__ __forceinline__ float fsig(float v) { return __builtin_amdgcn_rcpf(1.0f + __expf(-v)); }
__device__ __forceinline__ u32x4 pack8(const f32x4& a, const f32x4& b) { u32x4 w; w.x = cvt_pk_bf16(a[0], a[1]); w.y = cvt_pk_bf16(a[2], a[3]); w.z = cvt_pk_bf16(b[0], b[1]); w.w = cvt_pk_bf16(b[2], b[3]); return w; }

struct EpiProj {
    static constexpr bool PERM = true, AFTER_DRAIN = false; static constexpr int MID_T = 0;
    bf16_t* P; const float* rs;
    __device__ __forceinline__ void mid(f32x4 (&)[2][2][4][2], const Unit&, int, int, int, int) const {}
    __device__ __forceinline__ void operator()(const f32x4 (&acc)[2][2][4][2], const Unit& u, int wr, int wc, int fr, int fq) const {
        const int row0 = u.pm * BM + wr * 64 + fr, col0 = u.pn * BM + wc * 32 + 8 * fq; const bool gate = (u.pn * BM >= COL_G);
        float rv[2][4];
#pragma unroll
        for (int ai = 0; ai < 2; ++ai)
#pragma unroll
            for (int m = 0; m < 4; ++m) rv[ai][m] = rs[row0 + ai * HALF + m * 16];
#pragma unroll
        for (int ai = 0; ai < 2; ++ai)
#pragma unroll
            for (int m = 0; m < 4; ++m) { bf16_t* rowp = P + (size_t)(row0 + ai * HALF + m * 16) * NIN + col0;
#pragma unroll
                for (int bj = 0; bj < 2; ++bj) { f32x4 v0 = acc[ai][bj][m][0] * rv[ai][m], v1 = acc[ai][bj][m][1] * rv[ai][m];
                    if (gate) {
#pragma unroll
                        for (int i = 0; i < 4; ++i) { v0[i] = fsig(v0[i]); v1[i] = fsig(v1[i]); } }
                    *(u32x4*)(rowp + bj * HALF) = pack8(v0, v1); } }
    }
};
struct EpiGate {
    static constexpr bool PERM = true, AFTER_DRAIN = false; static constexpr int MID_T = AOW / BK;
    const bf16_t* P; bf16_t* Y;
    __device__ __forceinline__ void mid(f32x4 (&acc)[2][2][4][2], const Unit& u, int wr, int wc, int fr, int fq) const {
        int row0 = u.pm * BM + wr * 64 + fr, col0 = u.pn * BM + wc * 32 + 8 * fq;
        asm volatile("" : "+v"(row0), "+v"(col0));
#pragma unroll
        for (int ai = 0; ai < 2; ++ai) {
            u32x4 ga[4][2], gb[4][2];
#pragma unroll
            for (int m = 0; m < 4; ++m) { const bf16_t* gp = P + (size_t)(row0 + ai * HALF + m * 16) * NIN + COL_G + col0;
#pragma unroll
                for (int bj = 0; bj < 2; ++bj) { ga[m][bj] = *(const u32x4*)(gp + bj * HALF); gb[m][bj] = *(const u32x4*)(gp + D + bj * HALF); } }
#pragma unroll
            for (int m = 0; m < 4; ++m)
#pragma unroll
                for (int bj = 0; bj < 2; ++bj) { const u32x4 a = ga[m][bj], b = gb[m][bj];
                    f32x4& v0 = acc[ai][bj][m][0]; f32x4& v1 = acc[ai][bj][m][1];
                    v0[0] *= bflo(a.x) * __builtin_amdgcn_rcpf(fmaxf(bflo(b.x), 1e-30f)); v0[1] *= bfhi(a.x) * __builtin_amdgcn_rcpf(fmaxf(bfhi(b.x), 1e-30f));
                    v0[2] *= bflo(a.y) * __builtin_amdgcn_rcpf(fmaxf(bflo(b.y), 1e-30f)); v0[3] *= bfhi(a.y) * __builtin_amdgcn_rcpf(fmaxf(bfhi(b.y), 1e-30f));
                    v1[0] *= bflo(a.z) * __builtin_amdgcn_rcpf(fmaxf(bflo(b.z), 1e-30f)); v1[1] *= bfhi(a.z) * __builtin_amdgcn_rcpf(fmaxf(bfhi(b.z), 1e-30f));
                    v1[2] *= bflo(a.w) * __builtin_amdgcn_rcpf(fmaxf(bflo(b.w), 1e-30f)); v1[3] *= bfhi(a.w) * __builtin_amdgcn_rcpf(fmaxf(bfhi(b.w), 1e-30f)); }
            asm volatile("" ::: "memory"); }
    }
    __device__ __forceinline__ void operator()(const f32x4 (&acc)[2][2][4][2], const Unit& u, int wr, int wc, int fr, int fq) const {
        const int row0 = u.pm * BM + wr * 64 + fr, col0 = u.pn * BM + wc * 32 + 8 * fq;
#pragma unroll
        for (int ai = 0; ai < 2; ++ai) {
            u32x4 gb[4][2];
#pragma unroll
            for (int m = 0; m < 4; ++m)
#pragma unroll
                for (int bj = 0; bj < 2; ++bj) gb[m][bj] = *(const u32x4*)(P + (size_t)(row0 + ai * HALF + m * 16) * NIN + COL_G + D + col0 + bj * HALF);
#pragma unroll
            for (int m = 0; m < 4; ++m) { bf16_t* yp = Y + (size_t)(row0 + ai * HALF + m * 16) * D + col0;
#pragma unroll
                for (int bj = 0; bj < 2; ++bj) { const u32x4 b = gb[m][bj]; f32x4 v0 = acc[ai][bj][m][0], v1 = acc[ai][bj][m][1];
                    v0[0] *= bflo(b.x); v0[1] *= bfhi(b.x); v0[2] *= bflo(b.y); v0[3] *= bfhi(b.y); v1[0] *= bflo(b.z); v1[1] *= bfhi(b.z); v1[2] *= bflo(b.w); v1[3] *= bfhi(b.w);
                    *(u32x4*)(yp + bj * HALF) = pack8(v0, v1); } }
            asm volatile("" ::: "memory"); }
    }
};
template <bool F32IN>
struct EpiRes {
    static constexpr bool PERM = true, AFTER_DRAIN = false; static constexpr int MID_T = 0;
    const float* basef; const bf16_t* baseh; bf16_t* Hh;
    __device__ __forceinline__ void mid(f32x4 (&)[2][2][4][2], const Unit&, int, int, int, int) const {}
    __device__ __forceinline__ void operator()(const f32x4 (&acc)[2][2][4][2], const Unit& u, int wr, int wc, int fr, int fq) const {
        const int row0 = u.pm * BM + wr * 64 + fr, col0 = u.pn * BM + wc * 32 + 8 * fq;
#pragma unroll
        for (int ai = 0; ai < 2; ++ai) {
            if constexpr (F32IN) {
                f32x4 rb[4][2][2];
#pragma unroll
                for (int m = 0; m < 4; ++m) { const size_t off = (size_t)(row0 + ai * HALF + m * 16) * D + col0;
#pragma unroll
                    for (int bj = 0; bj < 2; ++bj) { rb[m][bj][0] = *(const f32x4*)(basef + off + bj * HALF); rb[m][bj][1] = *(const f32x4*)(basef + off + bj * HALF + 4); } }
#pragma unroll
                for (int m = 0; m < 4; ++m) { const size_t off = (size_t)(row0 + ai * HALF + m * 16) * D + col0;
#pragma unroll
                    for (int bj = 0; bj < 2; ++bj) *(u32x4*)(Hh + off + bj * HALF) = pack8(rb[m][bj][0] + acc[ai][bj][m][0], rb[m][bj][1] + acc[ai][bj][m][1]); }
            } else {
                u32x4 rb[4][2];
#pragma unroll
                for (int m = 0; m < 4; ++m) { const size_t off = (size_t)(row0 + ai * HALF + m * 16) * D + col0;
#pragma unroll
                    for (int bj = 0; bj < 2; ++bj) rb[m][bj] = *(const u32x4*)(baseh + off + bj * HALF); }
#pragma unroll
                for (int m = 0; m < 4; ++m) { const size_t off = (size_t)(row0 + ai * HALF + m * 16) * D + col0;
#pragma unroll
                    for (int bj = 0; bj < 2; ++bj) { const u32x4 w = rb[m][bj]; f32x4 a0 = acc[ai][bj][m][0], a1 = acc[ai][bj][m][1];
                        a0.x += __uint_as_float(w.x << 16); a0.y += __uint_as_float(w.x & 0xffff0000u); a0.z += __uint_as_float(w.y << 16); a0.w += __uint_as_float(w.y & 0xffff0000u);
                        a1.x += __uint_as_float(w.z << 16); a1.y += __uint_as_float(w.z & 0xffff0000u); a1.z += __uint_as_float(w.w << 16); a1.w += __uint_as_float(w.w & 0xffff0000u);
                        *(u32x4*)(Hh + off + bj * HALF) = pack8(a0, a1); } }
            }
            asm volatile("" ::: "memory"); }
    }
};
struct EpiSilu {
    static constexpr bool PERM = true, AFTER_DRAIN = false; static constexpr int MID_T = 0;
    bf16_t* HBp;
    __device__ __forceinline__ void mid(f32x4 (&)[2][2][4][2], const Unit&, int, int, int, int) const {}
    __device__ __forceinline__ void operator()(const f32x4 (&acc)[2][2][4][2], const Unit& u, int wr, int wc, int fr, int fq) const {
        const int row0 = u.pm * BM + wr * 64 + fr, col0 = u.pn * HALF + wc * 32 + 8 * fq;
#pragma unroll
        for (int ai = 0; ai < 2; ++ai)
#pragma unroll
            for (int m = 0; m < 4; ++m) { f32x4 v0, v1;
#pragma unroll
                for (int i = 0; i < 4; ++i) { const float g0 = acc[ai][0][m][0][i], g1 = acc[ai][0][m][1][i]; v0[i] = g0 * fsig(g0) * acc[ai][1][m][0][i]; v1[i] = g1 * fsig(g1) * acc[ai][1][m][1][i]; }
                *(u32x4*)(HBp + (size_t)(row0 + ai * HALF + m * 16) * DE + col0) = pack8(v0, v1); }
    }
};
struct EpiBf16 {
    static constexpr bool PERM = true, AFTER_DRAIN = false; static constexpr int MID_T = 0;
    bf16_t* O; int ldc;
    __device__ __forceinline__ void mid(f32x4 (&)[2][2][4][2], const Unit&, int, int, int, int) const {}
    __device__ __forceinline__ void operator()(const f32x4 (&acc)[2][2][4][2], const Unit& u, int wr, int wc, int fr, int fq) const {
        const int row0 = u.pm * BM + wr * 64 + fr, col0 = u.pn * BM + wc * 32 + 8 * fq;
#pragma unroll
        for (int ai = 0; ai < 2; ++ai)
#pragma unroll
            for (int m = 0; m < 4; ++m) { bf16_t* rowp = O + (size_t)(row0 + ai * HALF + m * 16) * ldc + col0;
#pragma unroll
                for (int bj = 0; bj < 2; ++bj) *(u32x4*)(rowp + bj * HALF) = pack8(acc[ai][bj][m][0], acc[ai][bj][m][1]); }
    }
};
struct GroupedOrder {
    const int* tile_e; int ntot, G, vcu;
    __device__ void init(const int* te, int ntiles, int G_, int vcu_) { tile_e = te; ntot = ntiles * 4; G = G_; vcu = vcu_; }
    __device__ bool next(int i, Unit& u) const {
        const int L = i * G + vcu; if (L >= ntot) return false;
        u.pm = L >> 2; u.pn = L & 3; u.pb = __builtin_amdgcn_readfirstlane(__hip_atomic_load(tile_e + (L >> 2), __ATOMIC_RELAXED, __HIP_MEMORY_SCOPE_AGENT)) * 4 + (L & 3); return true;
    }
    __device__ __forceinline__ void a_ready(const Unit&) const {}
    __device__ __forceinline__ void done(const Unit&) const {}
};

template <class Epi, class Sched, bool ALIGN_EPI = false, bool SP2 = false>
__device__ __forceinline__ void gemm_phase(PG8_LAS unsigned char* lds, const Gemm g, const Sched& S, const Epi& E, int wv) {
    const int tid = opaque_tid(wv), wid = __builtin_amdgcn_readfirstlane(tid >> 6), lane = tid & 63, wr = wid >> 2, wc = wid & 3, fr = lane & 15, fq = lane >> 4;
    const int K = g.K, nt = K / BK;
    unsigned voffA[2], voffB[2];
#pragma unroll
    for (int i = 0; i < 2; ++i) { int R, C; stage_rc(tid * 16 + i * 8192, R, C); const int Rb = Epi::PERM ? ((R & ~31) + perm32(R & 31)) : R;
        voffA[i] = (unsigned)(R * K + C) * 2u; voffB[i] = (unsigned)(Rb * K + C) * 2u; }
    const size_t kstep = (size_t)(BK * 2);
    const size_t hstep = (size_t)HALF * K * 2;
    const size_t tstep = 2 * hstep;
    const unsigned ldsw = (unsigned)wid * 1024u;
    const int aoff = lds_byte(wr * 64 + fr, fq * 8), boff = lds_byte(wc * 32 + fr, fq * 8);
#define PG8_SA(b, h) (((b) * 2 + (h)) * HTB)
#define PG8_SB(b, h) ((4 + (b) * 2 + (h)) * HTB)
#define PG8_STAGE(bufoff, gbase, voff) do { _Pragma("unroll") for (int _i = 0; _i < 2; ++_i) \
        __builtin_amdgcn_global_load_lds((const unsigned*)((const char*)(gbase) + (voff)[_i]), (PG8_LAS unsigned*)(lds + (bufoff) + ldsw + _i * 8192), 16, 0, 0); } while (0)
#define PG8_LDA(dst, b, h) do { _Pragma("unroll") for (int m = 0; m < 4; ++m) _Pragma("unroll") for (int k = 0; k < 2; ++k) dst[m][k] = *(const PG8_LAS bf16x8*)(lds + PG8_SA(b, h) + aoff + m * 2048 + k * 1024); } while (0)
#define PG8_LDB(dst, b, h) do { _Pragma("unroll") for (int n = 0; n < 2; ++n) _Pragma("unroll") for (int k = 0; k < 2; ++k) dst[n][k] = *(const PG8_LAS bf16x8*)(lds + PG8_SB(b, h) + boff + n * 2048 + k * 1024); } while (0)
#define PG8_MMA(ai, bj, At, Bt) do { __builtin_amdgcn_s_setprio(1); _Pragma("unroll") for (int m = 0; m < 4; ++m) _Pragma("unroll") for (int n = 0; n < 2; ++n) _Pragma("unroll") for (int k = 0; k < 2; ++k) \
        acc[ai][bj][m][n] = __builtin_amdgcn_mfma_f32_16x16x32_bf16(Bt[n][k], At[m][k], acc[ai][bj][m][n], 0, 0, 0); __builtin_amdgcn_s_setprio(0); } while (0)
#define PG8_WAIT_V(n) asm volatile("s_waitcnt vmcnt(" #n ")" ::: "memory")
#define PG8_WAIT_L(n) asm volatile("s_waitcnt lgkmcnt(" #n ")" ::: "memory")
#define PG8_BAR __builtin_amdgcn_s_barrier()
#define PG8_SCHED __builtin_amdgcn_sched_barrier(0)
    Unit cur, nxt; int ui = 0;
    if (!S.next(0, cur)) return;
    f32x4 acc[2][2][4][2];
#pragma unroll
    for (int a = 0; a < 2; ++a)
#pragma unroll
        for (int b = 0; b < 2; ++b)
#pragma unroll
            for (int m = 0; m < 4; ++m)
#pragma unroll
                for (int n = 0; n < 2; ++n) acc[a][b][m][n] = (f32x4){0.f, 0.f, 0.f, 0.f};
    bf16x8 At[4][2], B0[2][2], B1[2][2];
    const char* cA = (const char*)g.A + (size_t)cur.pm * tstep; const char* cB = (const char*)g.Bt + (size_t)cur.pb * tstep;
    S.a_ready(cur);
    if constexpr (SP2) {
        PG8_STAGE(PG8_SB(0, 0), cB, voffB); PG8_STAGE(PG8_SB(0, 1), cB + hstep, voffB); PG8_STAGE(PG8_SA(0, 0), cA, voffA); PG8_STAGE(PG8_SA(0, 1), cA + hstep, voffA);
        if (wr == 1) PG8_BAR;
        PG8_WAIT_V(2); PG8_BAR;
        PG8_STAGE(PG8_SB(1, 0), cB + kstep, voffB); PG8_STAGE(PG8_SA(1, 0), cA + kstep, voffA); PG8_STAGE(PG8_SB(1, 1), cB + hstep + kstep, voffB);
        PG8_WAIT_V(6); PG8_BAR;
    } else {
        PG8_STAGE(PG8_SB(0, 0), cB, voffB); PG8_STAGE(PG8_SA(0, 0), cA, voffA); PG8_STAGE(PG8_SB(0, 1), cB + hstep, voffB); PG8_STAGE(PG8_SA(0, 1), cA + hstep, voffA);
        if (wr == 1) PG8_BAR;
        PG8_WAIT_V(4); PG8_BAR;
        PG8_STAGE(PG8_SB(1, 0), cB + kstep, voffB); PG8_STAGE(PG8_SA(1, 0), cA + kstep, voffA); PG8_STAGE(PG8_SB(1, 1), cB + hstep + kstep, voffB);
        PG8_WAIT_V(6); PG8_BAR;
    }
    for (;;) {
        const bool has_next = S.next(ui + 1, nxt);
        const char* nA = has_next ? (const char*)g.A + (size_t)nxt.pm * tstep : cA; const char* nB = has_next ? (const char*)g.Bt + (size_t)nxt.pb * tstep : cB;
        for (int t = 0; t < nt; t += 2) {
            const bool last = (t == nt - 2);
            const char* a1 = cA + (size_t)(t + 1) * kstep;
            const char* a2 = last ? nA : cA + (size_t)(t + 2) * kstep; const char* b2 = last ? nB : cB + (size_t)(t + 2) * kstep;
            const char* a3 = a2 + kstep; const char* b3 = b2 + kstep;
            if (last && has_next) S.a_ready(nxt);
            if constexpr (Epi::MID_T > 0) { if (t == Epi::MID_T) E.mid(acc, cur, wr, wc, fr, fq); }
            if constexpr (SP2) {
            PG8_LDB(B0, 0, 0); PG8_LDB(B1, 0, 1); PG8_SCHED; PG8_LDA(At, 0, 0); PG8_STAGE(PG8_SA(1, 1), a1 + hstep, voffA);
            PG8_WAIT_V(8); PG8_WAIT_L(0); PG8_BAR; PG8_MMA(0, 0, At, B0); PG8_MMA(0, 1, At, B1); PG8_BAR; PG8_SCHED;
            PG8_LDA(At, 0, 1); PG8_STAGE(PG8_SB(0, 0), b2, voffB); PG8_STAGE(PG8_SB(0, 1), b2 + hstep, voffB); PG8_STAGE(PG8_SA(0, 0), a2, voffA);
            PG8_WAIT_V(8); PG8_WAIT_L(0); PG8_BAR; PG8_MMA(1, 0, At, B0); PG8_MMA(1, 1, At, B1); PG8_BAR; PG8_SCHED;
            PG8_LDB(B0, 1, 0); PG8_LDB(B1, 1, 1); PG8_SCHED; PG8_LDA(At, 1, 0); PG8_STAGE(PG8_SA(0, 1), a2 + hstep, voffA);
            PG8_WAIT_V(8); PG8_WAIT_L(0); PG8_BAR; PG8_MMA(0, 0, At, B0); PG8_MMA(0, 1, At, B1); PG8_BAR; PG8_SCHED;
            PG8_LDA(At, 1, 1); PG8_STAGE(PG8_SB(1, 0), b3, voffB); PG8_STAGE(PG8_SB(1, 1), b3 + hstep, voffB); PG8_STAGE(PG8_SA(1, 0), a3, voffA);
            PG8_WAIT_V(8); PG8_WAIT_L(0); PG8_BAR; PG8_MMA(1, 0, At, B0); PG8_MMA(1, 1, At, B1); PG8_BAR; PG8_SCHED;
            } else {
            PG8_LDB(B0, 0, 0); PG8_SCHED; PG8_LDA(At, 0, 0); PG8_STAGE(PG8_SA(1, 1), a1 + hstep, voffA);
            PG8_WAIT_L(8); PG8_BAR; PG8_WAIT_L(0); PG8_MMA(0, 0, At, B0); PG8_BAR; PG8_SCHED;
            PG8_LDB(B1, 0, 1); PG8_STAGE(PG8_SB(0, 0), b2, voffB);
            PG8_BAR; PG8_WAIT_L(0); PG8_MMA(0, 1, At, B1); PG8_BAR;
            PG8_LDA(At, 0, 1); PG8_STAGE(PG8_SA(0, 0), a2, voffA);
            PG8_BAR; PG8_WAIT_L(0); PG8_MMA(1, 0, At, B0); PG8_BAR; PG8_SCHED;
            PG8_STAGE(PG8_SB(0, 1), b2 + hstep, voffB);
            PG8_WAIT_V(6); PG8_BAR; PG8_MMA(1, 1, At, B1); PG8_BAR;
            PG8_LDB(B0, 1, 0); PG8_SCHED; PG8_LDA(At, 1, 0); PG8_STAGE(PG8_SA(0, 1), a2 + hstep, voffA);
            PG8_WAIT_L(8); PG8_BAR; PG8_WAIT_L(0); PG8_MMA(0, 0, At, B0); PG8_BAR; PG8_SCHED;
            PG8_LDB(B1, 1, 1); PG8_STAGE(PG8_SB(1, 0), b3, voffB);
            PG8_BAR; PG8_WAIT_L(0); PG8_MMA(0, 1, At, B1); PG8_BAR;
            PG8_LDA(At, 1, 1); PG8_STAGE(PG8_SA(1, 0), a3, voffA);
            PG8_BAR; PG8_WAIT_L(0); PG8_MMA(1, 0, At, B0); PG8_BAR; PG8_SCHED;
            PG8_STAGE(PG8_SB(1, 1), b3 + hstep, voffB);
            PG8_WAIT_V(6); PG8_BAR; PG8_MMA(1, 1, At, B1); PG8_BAR;
            }
        }
        if constexpr (ALIGN_EPI) { if (wr == 0) PG8_BAR; }
        if constexpr (!Epi::AFTER_DRAIN) { E(acc, cur, wr, wc, fr, fq); S.done(cur); }
        if (!has_next) break;
#pragma unroll
        for (int a = 0; a < 2; ++a)
#pragma unroll
            for (int b = 0; b < 2; ++b)
#pragma unroll
                for (int m = 0; m < 4; ++m)
#pragma unroll
                    for (int n = 0; n < 2; ++n) acc[a][b][m][n] = (f32x4){0.f, 0.f, 0.f, 0.f};
        cur = nxt; cA = nA; cB = nB; ++ui;
        if constexpr (ALIGN_EPI) { if (wr == 1) PG8_BAR; }
    }
    PG8_WAIT_V(0);
    if constexpr (!ALIGN_EPI) { if (wr == 0) PG8_BAR; }
    PG8_BAR;
    if constexpr (Epi::AFTER_DRAIN) { E.fused(acc, cur, wr, wc, fr, fq, lds, wid, lane); S.done(cur); }
#undef PG8_SA
#undef PG8_SB
#undef PG8_STAGE
#undef PG8_LDA
#undef PG8_LDB
#undef PG8_MMA
#undef PG8_WAIT_V
#undef PG8_WAIT_L
#undef PG8_BAR
#undef PG8_SCHED
}
}


namespace moe {
typedef short bf16x8 __attribute__((ext_vector_type(8)));
typedef short s16x4 __attribute__((ext_vector_type(4)));
constexpr int BK = 64, TILE_B = 256 * BK * 2, STAGE_B = 2 * TILE_B;
__device__ __forceinline__ int lds_byte2(int r, int c) { const int st = (r >> 4) * 2 + (c >> 5), ob = (r & 15) * 64 + (c & 31) * 2; return st * 1024 + (ob ^ (((ob >> 9) & 1) << 5)); }
__device__ __forceinline__ void stage_rc2(int b, int& R, int& C) { const int st = b >> 10, sb = b & 1023, swz = sb ^ (((sb >> 9) & 1) << 5); R = (st / 2) * 16 + swz / 64; C = (st % 2) * 32 + (swz % 64) / 2; }
__device__ __forceinline__ void glds16_asm(const void* sbase, unsigned voff, unsigned lds_dst) { unsigned keep;
    asm volatile("s_mov_b32 %0, m0\n\ts_mov_b32 m0, %3\n\ts_nop 0\n\tglobal_load_lds_dwordx4 %1, %2\n\ts_mov_b32 m0, %0" : "=&s"(keep) : "v"(voff), "s"(sbase), "s"(lds_dst) : "memory"); }
__device__ __forceinline__ s16x4 tr16(LAS const unsigned char* p) { return __builtin_bit_cast(s16x4, __builtin_amdgcn_ds_read_tr16_b64_v4i16((LAS s16x4*)p)); }

template <int MODE>
__device__ __forceinline__ void gemm_phase(LAS unsigned char* lds, const bf16_t* A, int K, const float* W0, const float* W1, bf16_t* O, const int* tile_e, const int* src_map, const float* rstd, const float* kgain, int* ready, int ntiles, int G_, int vcu, int wv) {
    const int tid = opaque_tid(wv), wid = __builtin_amdgcn_readfirstlane(tid >> 6), lane = tid & 63, wr = wid >> 2, wc = wid & 3, fr = lane & 15, fq = lane >> 4;
    const int nt = K / BK, ntot = ntiles * 4;
    const unsigned lds0 = (unsigned)(uintptr_t)lds;
    LAS unsigned* avl = (LAS unsigned*)(lds + 2 * STAGE_B + 1024) + 4 * tid;
    constexpr int NW = (MODE == 0) ? DE : D;
    unsigned avoff = 0u; if (MODE == 1) { int R, C; stage_rc2(wid * 1024 + lane * 16, R, C); avoff = (unsigned)(R * K + C) * 2u; }
    const int krow = (MODE == 0) ? 2 * (wid >> 1) + (lane >> 5) : wid;
    const int hcol = 4 * (lane & 31);
    const int bcol = (MODE == 0) ? 64 * (hcol >> 5) + 32 * (wid & 1) + (hcol & 31) : 4 * lane;
    const unsigned wsrcb = (unsigned)((MODE == 0) ? (lane >> 5) * NW + hcol : 4 * lane) * 4u;
    const int c32 = bcol & 31, pos = (bcol & ~31) + 16 * ((c32 >> 2) & 1) + 4 * (c32 >> 3);
    const int bw_even = krow * 512 + ((pos * 2) ^ ((krow & 3) << 5)), bw_odd = krow * 512 + ((pos * 2) ^ (((krow & 3) | 4) << 5));
    const int aread0 = lds_byte2(wr * 128 + fr, fq * 8);
    const int tq = fr >> 2, tp = fr & 3, fx = (tq | ((fq & 1) << 2)) << 5;
    int bread[4];
#pragma unroll
    for (int n = 0; n < 4; ++n) bread[n] = (8 * fq + tq) * 512 + (((wc * 64 + 16 * n + 4 * tp) * 2) ^ fx);
    auto wait_ready = [&](int rt_) {
        if (opaque_tid(wv) == 0) {
            unsigned sp = 0;
            while (__hip_atomic_load(ready + rt_, __ATOMIC_RELAXED, __HIP_MEMORY_SCOPE_AGENT) < 4) { __builtin_amdgcn_s_sleep(2); if (++sp > (1u << 22)) break; }
            __builtin_amdgcn_fence(__ATOMIC_ACQUIRE, "agent");
            asm volatile("s_waitcnt vmcnt(0)" ::: "memory");
        }
        __syncthreads();
    };
    auto set_avl = [&](int rt_, int par_) {
        const int t2 = opaque_tid(wv); int R, C; stage_rc2((t2 >> 6) * 1024 + (t2 & 63) * 16, R, C);
        LAS unsigned* av = (LAS unsigned*)(lds + 2 * STAGE_B + 1024 + par_ * 8192) + 4 * t2;
#pragma unroll
        for (int i = 0; i < 4; ++i) av[i] = (unsigned)src_map[rt_ * 256 + R + 64 * i] * (unsigned)(K * 2) + (unsigned)C * 2u;
    };
    auto mk_wrs = [&](int e_, int ct_) -> __amdgpu_buffer_rsrc_t {
        const float* Wbase = (MODE == 0 ? ((wid & 1) ? W1 : W0) + (size_t)e_ * K * NW + ct_ * 128 + (size_t)(2 * (wid >> 1)) * NW : W0 + (size_t)e_ * K * NW + ct_ * 256 + (size_t)wid * NW);
        const unsigned long long wb_u = (unsigned long long)(uintptr_t)Wbase;
        const unsigned wb_lo = __builtin_amdgcn_readfirstlane((unsigned)wb_u), wb_hi = __builtin_amdgcn_readfirstlane((unsigned)(wb_u >> 32));
        return __builtin_amdgcn_make_buffer_rsrc((void*)(uintptr_t)(((unsigned long long)wb_hi << 32) | wb_lo), (short)0, (int)(K * NW * 4), 0x00020000);
    };
    int rt, ct;
    { const int L = (MODE == 1 ? G_ - 1 - vcu : vcu); if (L >= ntot) return; rt = L >> 2; ct = L & 3; }
    if (MODE == 1) wait_ready(rt);
    int par = 0;
    if (MODE == 0) set_avl(rt, 0);
    __amdgpu_buffer_rsrc_t wrs = mk_wrs(__builtin_amdgcn_readfirstlane(__hip_atomic_load(tile_e + rt, __ATOMIC_RELAXED, __HIP_MEMORY_SCOPE_AGENT)), ct);
    const bf16_t* Ab = A + (size_t)rt * 256 * K;
    f32x4 acc[8][4];
    f32x4 rb[8]; float gv = 1.f;
#define MOE_SA(b) (lds + (b) * STAGE_B)
#define MOE_SB(b) (lds + (b) * STAGE_B + TILE_B)
#define MOE_GLDS_A(buf, kt, Abx, parx) do { u32x4 vo_ = {avoff, avoff, avoff, avoff}; if (MODE == 0) vo_ = *(LAS const u32x4*)((LAS unsigned*)(lds + 2 * STAGE_B + 1024 + (parx) * 8192) + 4 * opaque_tid(wv));     \
        _Pragma("unroll") for (int i = 0; i < 4; ++i) \
        glds16_asm((MODE == 0 ? A : (Abx) + (size_t)i * 64 * K) + (kt) * BK, vo_[i], (unsigned)__builtin_amdgcn_readfirstlane(lds0 + (buf) * STAGE_B + wid * 1024 + i * 8192)); } while (0)
#define MOE_ISSUE_B(rs_, kt) do { if (MODE == 0) gv = kgain[(kt) * BK + (opaque_tid(wv) & 63)];     \
        _Pragma("unroll") for (int q = 0; q < 8; ++q) rb[q] = __builtin_bit_cast(f32x4, __builtin_amdgcn_raw_buffer_load_b128(rs_, (int)wsrcb, (int)(((kt) * BK + 8 * q) * NW * 4), 0)); } while (0)
#define MOE_WRITE_B(buf, kt) do { const int l_ = opaque_tid(wv) & 63;     \
        const int kr_ = (MODE == 0) ? 2 * (wid >> 1) + (l_ >> 5) : wid, hc_ = 4 * (l_ & 31), bc_ = (MODE == 0) ? 64 * (hc_ >> 5) + 32 * (wid & 1) + (hc_ & 31) : 4 * l_; \
        const int c3_ = bc_ & 31, ps_ = (bc_ & ~31) + 16 * ((c3_ >> 2) & 1) + 4 * (c3_ >> 3); \
        const int be_ = kr_ * 512 + ((ps_ * 2) ^ ((kr_ & 3) << 5)), bo_ = be_ ^ 128; \
        float gq_[8]; if (MODE == 0) { _Pragma("unroll") for (int q = 0; q < 8; ++q) gq_[q] = __builtin_bit_cast(float, __builtin_amdgcn_ds_bpermute((8 * q + kr_) * 4, __builtin_bit_cast(int, gv))); }     \
        _Pragma("unroll") for (int q = 0; q < 8; ++q) { u32x2 w; \
            if (MODE == 0) { w.x = pk2(rb[q].x * gq_[q], rb[q].y * gq_[q]); w.y = pk2(rb[q].z * gq_[q], rb[q].w * gq_[q]); } else { w.x = pk2(rb[q].x, rb[q].y); w.y = pk2(rb[q].z, rb[q].w); } \
            *(LAS u32x2*)(MOE_SB(buf) + ((q & 1) ? bo_ : be_) + q * 4096) = w; } } while (0)
#define MOE_COMPUTE(cur) do { __builtin_amdgcn_sched_barrier(0); \
            _Pragma("unroll") for (int ks = 0; ks < 2; ++ks) { \
                bf16x8 Bf[4]; \
                _Pragma("unroll") for (int n = 0; n < 4; ++n) { const s16x4 b0 = tr16(MOE_SB(cur) + bread[n] + ks * 16384), b1 = tr16(MOE_SB(cur) + bread[n] + ks * 16384 + 2048); Bf[n] = __builtin_shufflevector(b0, b1, 0, 1, 2, 3, 4, 5, 6, 7); } \
                _Pragma("unroll") for (int mh = 0; mh < 2; ++mh) { bf16x8 At[4]; \
                    _Pragma("unroll") for (int m = 0; m < 4; ++m) At[m] = *(LAS const bf16x8*)(MOE_SA(cur) + aread0 + (4 * mh + m) * 2048 + ks * 1024); \
                    _Pragma("unroll") for (int m = 0; m < 4; ++m) _Pragma("unroll") for (int n = 0; n < 4; ++n) acc[4 * mh + m][n] = __builtin_amdgcn_mfma_f32_16x16x32_bf16(Bf[n], At[m], acc[4 * mh + m][n], 0, 0, 0); \
                    __builtin_amdgcn_sched_barrier(0); } } } while (0)
#define MOE_END8() do { asm volatile("s_waitcnt vmcnt(8) lgkmcnt(0)" ::: "memory"); __builtin_amdgcn_s_barrier(); } while (0)
#define MOE_END0() do { asm volatile("s_waitcnt vmcnt(0) lgkmcnt(0)" ::: "memory"); __builtin_amdgcn_s_barrier(); } while (0)
#define MOE_STEP(cur, t) do { int tt_ = (t); asm volatile("" : "+s"(tt_));     \
        const bool own1 = tt_ + 1 < nt, own2 = tt_ + 2 < nt; \
        if (own1 || hn) { MOE_WRITE_B(1 - (cur), (own1 ? tt_ + 1 : 0)); __builtin_amdgcn_sched_barrier(0); MOE_GLDS_A(1 - (cur), (own1 ? (t) + 1 : 0), (own1 ? Ab : nAb), (own1 ? par : (par ^ 1))); } \
        if (MODE == 1 && (cur) == 0 && hn && tt_ == nt - 2) wait_ready(nrt); \
        if (own2 || hn) MOE_ISSUE_B((own2 ? wrs : nwrs), (own2 ? (t) + 2 : (t) + 2 - nt)); \
        MOE_COMPUTE(cur); \
        if (own2 || hn) MOE_END8(); else MOE_END0(); } while (0)
    MOE_ISSUE_B(wrs, 0); MOE_WRITE_B(0, 0); MOE_GLDS_A(0, 0, Ab, 0); MOE_ISSUE_B(wrs, 1);
    MOE_END0();
    int pend = -1;
    for (int ui = 0;; ++ui) {
        const int Ln = (ui + 1) * G_ + (MODE == 1 ? G_ - 1 - vcu : vcu);
        const bool hn = Ln < ntot;
        const int nrt = Ln >> 2, nct = Ln & 3;
        __amdgpu_buffer_rsrc_t nwrs = wrs; const bf16_t* nAb = Ab;
        if (hn) {
            nwrs = mk_wrs(__builtin_amdgcn_readfirstlane(__hip_atomic_load(tile_e + nrt, __ATOMIC_RELAXED, __HIP_MEMORY_SCOPE_AGENT)), nct);
            nAb = A + (size_t)nrt * 256 * K;
            if (MODE == 0) set_avl(nrt, par ^ 1);
        }
        float zf = 0.f; asm volatile("" : "+v"(zf));
#pragma unroll
        for (int m = 0; m < 8; ++m)
#pragma unroll
            for (int n = 0; n < 4; ++n) acc[m][n] = (f32x4){zf, zf, zf, zf};
        for (int t = 0; t < nt; t += 2) {
            MOE_STEP(0, t);
            int t0_ = t; asm volatile("" : "+s"(t0_));
            if (MODE == 0 && t0_ == 0 && pend >= 0) { if (opaque_tid(wv) == 0) __hip_atomic_fetch_add(ready + pend, 1, __ATOMIC_RELAXED, __HIP_MEMORY_SCOPE_AGENT); }
            MOE_STEP(1, t + 1);
        }
        const int tid_e = opaque_tid(wv), fr_e = tid_e & 15, fq_e = (tid_e >> 4) & 3;
        const int row0 = rt * 256 + wr * 128 + fr_e;
        if (MODE == 0) {
            const unsigned long long ob_u = (unsigned long long)(uintptr_t)O;
            const unsigned ob_lo = (unsigned)__builtin_amdgcn_readfirstlane((unsigned)ob_u), ob_hi = (unsigned)__builtin_amdgcn_readfirstlane((unsigned)(ob_u >> 32));
            const __amdgpu_buffer_rsrc_t ors = __builtin_amdgcn_make_buffer_rsrc((void*)(uintptr_t)(((unsigned long long)ob_hi << 32) | ob_lo), (short)0, (int)((size_t)PMAX * DE * 2), 0x00020000);
            const int col0 = ct * 128 + wc * 32 + 8 * fq_e;
            float rs[8];
#pragma unroll
            for (int m = 0; m < 8; ++m) rs[m] = rstd[row0 + m * 16];
#pragma unroll
            for (int m = 0; m < 8; ++m) { f32x4 v0, v1;
#pragma unroll
                for (int i = 0; i < 4; ++i) { const float g0 = acc[m][0][i] * rs[m], g1 = acc[m][1][i] * rs[m]; v0[i] = g0 * pg8::fsig(g0) * (acc[m][2][i] * rs[m]); v1[i] = g1 * pg8::fsig(g1) * (acc[m][3][i] * rs[m]); }
                __builtin_amdgcn_raw_buffer_store_b128(pg8::pack8(v0, v1), ors, (int)(((unsigned)(row0 + m * 16) * DE + col0) * 2u), 0, 16);
                __builtin_amdgcn_sched_barrier(0); }
            pend = rt;
        } else {
            const int col0 = ct * 256 + wc * 64 + 8 * fq_e;
#pragma unroll
            for (int m = 0; m < 8; ++m) { bf16_t* rp = O + (size_t)(row0 + m * 16) * D + col0;
                *(u32x4*)rp = pg8::pack8(acc[m][0], acc[m][1]); *(u32x4*)(rp + 32) = pg8::pack8(acc[m][2], acc[m][3]); __builtin_amdgcn_sched_barrier(0); }
        }
        if (!hn) break;
        rt = nrt; ct = nct; wrs = nwrs; Ab = nAb; par ^= 1;
    }
    if (MODE == 0) {
        asm volatile("s_waitcnt vmcnt(0)" ::: "memory"); __syncthreads();
        if (opaque_tid(wv) == 0) __hip_atomic_fetch_add(ready + pend, 1, __ATOMIC_RELAXED, __HIP_MEMORY_SCOPE_AGENT);
    }
#undef MOE_STEP
#undef MOE_END8
#undef MOE_END0
#undef MOE_COMPUTE
#undef MOE_SA
#undef MOE_SB
#undef MOE_GLDS_A
#undef MOE_ISSUE_B
#undef MOE_WRITE_B
}
}

__device__ __forceinline__ void transpose_item(const float* W, int ldw, int k0, int n0, bf16_t* WT, size_t drow0, int dk0, int ldk, LAS float* scr, int lane, const float* ksc = nullptr) {
    f32x4 v[16];
#pragma unroll
    for (int i = 0; i < 16; ++i) v[i] = *(const f32x4*)(W + (size_t)(k0 + 4 * i + (lane >> 4)) * ldw + n0 + 4 * (lane & 15));
    if (ksc) {
#pragma unroll
        for (int i = 0; i < 16; ++i) { const float s = ksc[k0 + 4 * i + (lane >> 4)]; v[i].x *= s; v[i].y *= s; v[i].z *= s; v[i].w *= s; } }
#pragma unroll
    for (int i = 0; i < 16; ++i) { const int kk = 4 * i + (lane >> 4), nb4 = 4 * (lane & 15);
#pragma unroll
        for (int e = 0; e < 4; ++e) scr[kk * 64 + ((nb4 + e + kk) & 63)] = v[i][e]; }
    asm volatile("s_waitcnt lgkmcnt(0)" ::: "memory");
    const int cch = lane & 7;
#pragma unroll
    for (int j = 0; j < 8; ++j) { const int n = (lane >> 3) + 8 * j; float f[8];
#pragma unroll
        for (int q = 0; q < 8; ++q) { const int kk = 8 * cch + q; f[q] = scr[kk * 64 + ((n + kk) & 63)]; }
        u32x4 o; o.x = pk2(f[0], f[1]); o.y = pk2(f[2], f[3]); o.z = pk2(f[4], f[5]); o.w = pk2(f[6], f[7]);
        *(u32x4*)(WT + (drow0 + n) * (size_t)ldk + dk0 + 8 * cch) = o; }
    asm volatile("s_waitcnt lgkmcnt(0)" ::: "memory");
}
__device__ __forceinline__ void ph_prologue(const Ctx& c, int vcu, int nb, LAS unsigned char* lds, int wv) {
    const int tid = opaque_tid(wv);
    const int lane = tid & 63, wave = __builtin_amdgcn_readfirstlane(tid >> 6);
    LAS float* scr = (LAS float*)(lds + wave * 16384);
    const int gw = vcu * NWAVES + wave, ngw = nb * NWAVES;
    constexpr int I_IN = (D / 64) * (NIN / 64), I_PA = (AOW / 64) * (D / 64), I_OUT = (D / 64) * (D / 64);
    constexpr int I_DENSE = DEPTH * (I_IN + I_PA + I_OUT);
    for (int it = gw; it < I_DENSE; it += ngw) {
        int r = it;
        if (r < I_DENSE) {
            const int l = r / (I_IN + I_PA + I_OUT); r -= l * (I_IN + I_PA + I_OUT);
            if (r < I_IN) { const int kb = r / (NIN / 64), nbk = r % (NIN / 64); transpose_item(c.w_in + (size_t)l * D * NIN, NIN, 64 * kb, 64 * nbk, c.WIN() + (size_t)l * NIN * D, 64 * nbk, 64 * kb, D, scr, lane, c.norm_mix_g + (size_t)l * D); continue; }
            r -= I_IN;
            if (r < I_PA) { const int kb = r / (D / 64), nbk = r % (D / 64); transpose_item(c.w_proj_attn + (size_t)l * AOW * D, D, 64 * kb, 64 * nbk, c.WP() + (size_t)l * D * A2W, 64 * nbk, 64 * kb, A2W, scr, lane); continue; }
            r -= I_PA;
            { const int kb = r / (D / 64), nbk = r % (D / 64); transpose_item(c.w_out + (size_t)l * D * D, D, 64 * kb, 64 * nbk, c.WOUT() + (size_t)l * D * D, 64 * nbk, 64 * kb, D, scr, lane); continue; }
        }
    }
    for (int it = gw; it < DEPTH * 160; it += ngw) {
        const int l = it / 160, f = it % 160, ks = f / 5, nt = f % 5, g = lane >> 4, n = 16 * nt + (lane & 15);
        float wv[8];
#pragma unroll
        for (int j = 0; j < 8; ++j) { const int k = 32 * ks + 8 * g + j; float w = 0.f;
            if (n < NEG) w = c.w_rg[((size_t)l * D + k) * NEG + n];
            else if (n < NEG + NE) w = c.w_re[(((size_t)l * NEG + ((n - NEG) >> 3)) * D + k) * EPG + ((n - NEG) & 7)];
            wv[j] = w * c.norm_ffn_g[(size_t)l * D + k]; }
        u32x4 h, lo;
        const unsigned h0 = f2bf(wv[0]), h1 = f2bf(wv[1]), h2 = f2bf(wv[2]), h3 = f2bf(wv[3]), h4 = f2bf(wv[4]), h5 = f2bf(wv[5]), h6 = f2bf(wv[6]), h7 = f2bf(wv[7]);
        h.x = h0 | (h1 << 16); h.y = h2 | (h3 << 16); h.z = h4 | (h5 << 16); h.w = h6 | (h7 << 16);
        lo.x = pk2(wv[0] - __uint_as_float(h0 << 16), wv[1] - __uint_as_float(h1 << 16)); lo.y = pk2(wv[2] - __uint_as_float(h2 << 16), wv[3] - __uint_as_float(h3 << 16));
        lo.z = pk2(wv[4] - __uint_as_float(h4 << 16), wv[5] - __uint_as_float(h5 << 16)); lo.w = pk2(wv[6] - __uint_as_float(h6 << 16), wv[7] - __uint_as_float(h7 << 16));
        u32x4* dst = (u32x4*)c.WR() + (size_t)l * 2 * WR_FRAGS;
        dst[f * 64 + lane] = h; dst[WR_FRAGS + f * 64 + lane] = lo;
    }
    ph_x_to_h(c.x, c.H(), c.RSTDM(), vcu, nb, wv);
    ph_fold_wpc(c, vcu, nb, wv);
}

#define XB_TMO      128
#define XB_XCNT(j)  (256  + 64 * (j))
#define XB_XSUB(j)  (1280 + 64 * (j))
#define XB_XGEN(j)  (2304 + 64 * (j))
#define XB_TOP      3328
#define XB_TOPGEN   3392
#define XCD_BAR_WORDS 3456
#define XB_SPIN_CAP (1u << 18)

__device__ __forceinline__ unsigned xb_ld(unsigned* p)              { return __hip_atomic_load(p, __ATOMIC_RELAXED, __HIP_MEMORY_SCOPE_AGENT); }
__device__ __forceinline__ unsigned xb_add(unsigned* p, unsigned v) { return __hip_atomic_fetch_add(p, v, __ATOMIC_RELAXED, __HIP_MEMORY_SCOPE_AGENT); }
__device__ __forceinline__ unsigned xb_xcc_id() { return (unsigned)__builtin_amdgcn_s_getreg((3 << 11) | 20) & 0xFu; }
#define XB_SPIN(cond, bar) do { unsigned _sp = 0; while (cond) { __builtin_amdgcn_s_sleep(1); \
    if ((++_sp & 255u) == 0u) { if (xb_ld(&(bar)[XB_TMO])) break; if (_sp > XB_SPIN_CAP) { atomicAdd(&(bar)[XB_TMO], 1u); break; } } } } while (0)

struct XcdBarrier {
    unsigned* bar; unsigned x;
    volatile LAS unsigned* st;
};

__device__ __forceinline__ XcdBarrier xcd_barrier_post(unsigned* bar, volatile LAS unsigned* st, bool t0) {
    XcdBarrier b; b.bar = bar; b.x = xb_xcc_id(); b.st = st;
    if (t0) st[2] = xb_add(&bar[XB_XCNT(b.x)], 1u);
    return b;
}
__device__ __forceinline__ void xcd_barrier_complete(unsigned* bar, unsigned x, unsigned& nloc, unsigned& nx) {
    const unsigned G = gridDim.x * gridDim.y * gridDim.z;
    unsigned sum, cnt, mine, sp = 0u;
    for (;;) {
        sum = 0u; cnt = 0u; mine = 0u;
#pragma unroll
        for (unsigned j = 0; j < 16; ++j) { const unsigned c = xb_ld(&bar[XB_XCNT(j)]); sum += c; cnt += (c > 0u) ? 1u : 0u; mine = (j == x) ? c : mine; }
        if (sum == G) break;
        __builtin_amdgcn_s_sleep(1);
        if ((++sp & 255u) == 0u) { if (xb_ld(&bar[XB_TMO])) break; if (sp > XB_SPIN_CAP) { atomicAdd(&bar[XB_TMO], 1u); break; } }
    }
    nloc = mine > 0u ? mine : 1u; nx = cnt > 0u ? cnt : 1u;
}

__device__ __forceinline__ void xcd_barrier(const XcdBarrier& b, bool t0, bool light = false) {
    asm volatile("s_waitcnt vmcnt(0)" ::: "memory");
    __syncthreads();
    if (t0) {
        unsigned* bar = b.bar;
        __builtin_amdgcn_s_waitcnt(0);
        unsigned nloc = b.st[0], nx = b.st[1];
        if (nloc == 0u) { xcd_barrier_complete(bar, b.x, nloc, nx); b.st[0] = nloc; b.st[1] = nx; }
        const unsigned old = xb_add(&bar[XB_XSUB(b.x)], 1u);
        const unsigned gen = old / nloc;
        if (old + 1u == (gen + 1u) * nloc) {
            if (!light) {
            __builtin_amdgcn_fence(__ATOMIC_RELEASE, "agent");
            asm volatile("s_waitcnt vmcnt(0)" ::: "memory");
            const unsigned og = xb_add(&bar[XB_TOP], 1u);
            const unsigned tg = og / nx;
            if (og + 1u == (tg + 1u) * nx) xb_add(&bar[XB_TOPGEN], 1u);
            else XB_SPIN(xb_ld(&bar[XB_TOPGEN]) == tg, bar);
            }
            __builtin_amdgcn_fence(__ATOMIC_ACQUIRE, "agent");
            xb_add(&bar[XB_XGEN(b.x)], 1u);
            asm volatile("s_waitcnt vmcnt(0)" ::: "memory");
        } else {
            XB_SPIN(xb_ld(&bar[XB_XGEN(b.x)]) == gen, bar);
            __builtin_amdgcn_fence(__ATOMIC_ACQUIRE, "agent");
            asm volatile("s_waitcnt vmcnt(0)" ::: "memory");
        }
    }
    __syncthreads();
}

#ifndef MK_PROBE_REP
#define MK_PROBE_REP 0u
#endif
#ifndef MK_PROBE_L
#define MK_PROBE_L -1
#endif
#ifndef MK_XCD_BARRIER
#define MK_XCD_BARRIER 1
#endif
#ifndef MK_PER_PHASE
#define MK_PER_PHASE 0
#endif
constexpr int RING_BYTES = 131072, LDS_BYTES = 150528;
constexpr int PPL = 8;
constexpr int NPHASE = 1 + PPL * DEPTH;
struct Args { Ctx c; int ph_lo, ph_hi; };
namespace cg = cooperative_groups;

typedef const __attribute__((address_space(4))) Args* KArgsP;
#define LOAD_CTX() Ctx c; c.x = kp->c.x; c.rel_bias = kp->c.rel_bias; c.norm_mix_g = kp->c.norm_mix_g; c.w_in = kp->c.w_in; c.pool_w = kp->c.pool_w; c.pool_scale = kp->c.pool_scale; \
    c.w_proj_attn = kp->c.w_proj_attn; c.w_proj_pool = kp->c.w_proj_pool; c.w_out = kp->c.w_out; c.norm_ffn_g = kp->c.norm_ffn_g; c.w_rg = kp->c.w_rg; c.w_re = kp->c.w_re; \
    c.w_gate = kp->c.w_gate; c.w_up = kp->c.w_up; c.w_down = kp->c.w_down; c.norm_final_g = kp->c.norm_final_g; c.out = kp->c.out; c.ws = kp->c.ws
template <int KIND> __device__ __forceinline__ void run_phase(KArgsP kp, int l, LAS unsigned char* lds, int wv) {
    asm volatile("" : "+s"(kp));
    const int G_ = gridDim.x;
    int bx = blockIdx.x;
    int vcu = (G_ % 8 == 0) ? (bx % 8) * (G_ / 8) + bx / 8 : bx;
#if MK_XCD_BARRIER && !MK_PER_PHASE
    if constexpr (KIND != -1) { LAS const unsigned* misc = (LAS const unsigned*)(lds + RING_BYTES);
        vcu = __builtin_amdgcn_readfirstlane((int)misc[12]); bx = __builtin_amdgcn_readfirstlane((int)misc[13]); }
#endif
    LOAD_CTX();
    if constexpr (KIND == -1) ph_prologue(c, vcu, G_, lds, wv);
    else if constexpr (KIND == 0) { pg8::Gemm g{c.H(), c.WIN() + (size_t)l * NIN * D, T, NIN, D}; pg8::StaticOrder S; S.init(T, NIN, G_, bx);
        pg8::EpiProj E{c.PROJ(), c.RSTDM()}; pg8::gemm_phase<pg8::EpiProj, pg8::StaticOrder, true, true>(lds, g, S, E, wv); }
    else if constexpr (KIND == 1) { ph_attention(c, vcu, G_, lds, wv); ph_pool(c, vcu, G_, lds, wv); }
    else if constexpr (KIND == 2) { }
    else if constexpr (KIND == 3) { pg8::Gemm g{c.A2(), c.WP() + (size_t)l * D * A2W, T, D, A2W}; pg8::StaticOrder S; S.init(T, D, G_, bx);
        {
            pg8::Unit u; if (S.next(0, u)) {
                ph_merge64(c, u.pm * 256 + u.pn * 64, wv);
                asm volatile("s_waitcnt vmcnt(0)" ::: "memory"); __syncthreads();
                if (opaque_tid(wv) == 0) { int* pc = c.PANEL() + (l * 64 + u.pm) * 16;
                    __hip_atomic_fetch_add(pc, 1, __ATOMIC_RELAXED, __HIP_MEMORY_SCOPE_AGENT);
                    unsigned sp = 0; while (__hip_atomic_load(pc, __ATOMIC_RELAXED, __HIP_MEMORY_SCOPE_AGENT) < 4) { __builtin_amdgcn_s_sleep(1); if (++sp > (1u << 22)) break; }
                    __builtin_amdgcn_fence(__ATOMIC_ACQUIRE, "agent"); asm volatile("s_waitcnt vmcnt(0)" ::: "memory"); }
                __syncthreads(); } }
        pg8::EpiGate E{c.PROJ(), c.Y()}; pg8::gemm_phase<pg8::EpiGate, pg8::StaticOrder, true, true>(lds, g, S, E, wv); }
    else if constexpr (KIND == 4) { pg8::Gemm g{c.Y(), c.WOUT() + (size_t)l * D * D, T, D, D}; pg8::StaticOrder S; S.init(T, D, G_, bx);
        pg8::EpiRes<false> E{c.x, c.H(), c.H()}; pg8::gemm_phase<pg8::EpiRes<false>, pg8::StaticOrder, true, true>(lds, g, S, E, wv); }
    else if constexpr (KIND == 5) ph_router(c, l, vcu, G_, lds, wv);
    else if constexpr (KIND == 6) ph_scatter(c, l, vcu, G_, (LAS int*)lds, wv);
    else if constexpr (KIND == 7) { const int ntiles = __builtin_amdgcn_readfirstlane(__hip_atomic_load(c.META(), __ATOMIC_RELAXED, __HIP_MEMORY_SCOPE_AGENT));
        moe::gemm_phase<0>(lds, c.H(), D, c.w_gate + (size_t)l * NE * D * DE, c.w_up + (size_t)l * NE * D * DE, c.HB(), c.TILEE(), c.SRC(), c.RS(), c.norm_ffn_g + (size_t)l * D, c.READY() + l * 256, ntiles, G_, vcu, wv);
        moe::gemm_phase<1>(lds, c.HB(), DE, c.w_down + (size_t)l * NE * DE * D, c.w_down + (size_t)l * NE * DE * D, c.YPAD(), c.TILEE(), c.SRC(), c.RS(), c.norm_ffn_g, c.READY() + l * 256, ntiles, G_, vcu, wv); }
    else if constexpr (KIND == 8) { }
    else ph_combine(c, l, vcu, G_, wv);
}
__device__ __forceinline__ void seam(KArgsP kp, LAS unsigned char* lds, int wv, bool light = false) {
    const bool t0 = (opaque_tid(wv) == 0);
#if MK_XCD_BARRIER
    XcdBarrier b; b.bar = (unsigned*)(kp->c.ws + WS_CTL + CT_BAR); b.x = xb_xcc_id(); b.st = (volatile LAS unsigned*)(lds + RING_BYTES) + 8;
#if !MK_PER_PHASE
    light = light && (b.st[3] != 0u);
#else
    light = false;
#endif
    xcd_barrier(b, t0, light);
#else
    cg::this_grid().sync();
#endif
}
__device__ __forceinline__ void setup_map(KArgsP kp, LAS unsigned char* lds, int wv) {
#if MK_XCD_BARRIER && !MK_PER_PHASE
    volatile LAS unsigned* misc = (volatile LAS unsigned*)(lds + RING_BYTES);
    if (opaque_tid(wv) == 0) {
        unsigned* bar = (unsigned*)(kp->c.ws + WS_CTL + CT_BAR);
        bool uni = (gridDim.x == 256u) && (gridDim.y * gridDim.z == 1u);
#pragma unroll
        for (unsigned j = 0; j < 16; ++j) { const unsigned cj = xb_ld(&bar[XB_XCNT(j)]); uni = uni && (cj == (j < 8u ? 32u : 0u)); }
        const unsigned x = xb_xcc_id(), r = misc[10];
        uni = uni && (x < 8u) && (r < 32u);
        const unsigned bxr = blockIdx.x;
        misc[11] = uni ? 1u : 0u;
        misc[12] = uni ? (x * 32u + r) : ((bxr % 8u) * (gridDim.x / 8u) + bxr / 8u);
        misc[13] = uni ? (r * 8u + x) : bxr;
    }
    __syncthreads();
#endif
}
__global__ void __launch_bounds__(NTHR, 2) mega(Args a) {
    extern __shared__ __attribute__((aligned(16))) unsigned char lds_raw[];
    LAS unsigned char* lds = (LAS unsigned char*)lds_raw;
    KArgsP kp = (KArgsP)__builtin_amdgcn_kernarg_segment_ptr();
#if !MK_PER_PHASE && MK_XCD_BARRIER
    const int wv = __builtin_amdgcn_readfirstlane((int)threadIdx.x >> 6);
    { volatile LAS unsigned* misc = (volatile LAS unsigned*)(lds + RING_BYTES); const int t = opaque_tid(wv);
      if (t < 16) misc[t] = 0u;
      __syncthreads();
      (void)xcd_barrier_post((unsigned*)(kp->c.ws + WS_CTL + CT_BAR), misc + 8, t == 0); }
#endif
    const int ph_lo = kp->ph_lo, ph_hi = kp->ph_hi;
#define LIGHT_SEAM(ph_) ((((ph_) - 1) % PPL >= 1 && ((ph_) - 1) % PPL <= 4) || (((ph_) - 1) % PPL == 0 && (ph_) > 1))
#define RUN(ph, KIND, L) do { const int ph_ = (ph); if (ph_lo <= ph_ && ph_ < ph_hi) { if (ph_ > ph_lo) seam(kp, lds, wv, LIGHT_SEAM(ph_)); if (ph_ == 1 && ph_lo == 0) setup_map(kp, lds, wv); run_phase<KIND>(kp, (L), lds, wv); \
        if (((MK_PROBE_REP >> ((KIND) + 1)) & 1) && (MK_PROBE_L < 0 || (L) == MK_PROBE_L)) { seam(kp, lds, wv); run_phase<KIND>(kp, (L), lds, wv); } } } while (0)
    RUN(0, -1, 0);
#define LAYER(l) do { constexpr int b0 = 1 + PPL * (l); \
        RUN(b0 + 0, 0, l); RUN(b0 + 1, 1, l); RUN(b0 + 2, 3, l); RUN(b0 + 3, 4, l); \
        RUN(b0 + 4, 5, l); RUN(b0 + 5, 6, l); RUN(b0 + 6, 7, l); RUN(b0 + 7, 9, l); } while (0)
    static_assert(DEPTH == 2, "two layers written out");
    LAYER(0); LAYER(1);
#undef LAYER
#undef RUN
}

extern "C" void kernel_launch(void* const* d_in, const int* in_sizes, int n_in, void* d_out, int out_size, void* d_ws, size_t ws_size, hipStream_t stream) {
    static int ready = 0;
    if (ready == 0) {
        if (n_in != 16 || in_sizes[0] != T * D || out_size != T * D || ws_size < WS_END) {
            fprintf(stderr, "kernel_launch: unexpected shapes: n_in %d in0 %d out %d ws %zu (need %zu)\n", n_in, n_in > 0 ? in_sizes[0] : -1, out_size, ws_size, (size_t)WS_END); ready = -1; return; }
        if (hipFuncSetAttribute((const void*)mega, hipFuncAttributeMaxDynamicSharedMemorySize, LDS_BYTES) != hipSuccess) { fprintf(stderr, "kernel_launch: hipFuncSetAttribute failed\n"); ready = -1; return; }
        int per_cu = 0;
        if (hipOccupancyMaxActiveBlocksPerMultiprocessor(&per_cu, (const void*)mega, NTHR, LDS_BYTES) != hipSuccess || per_cu < 1) fprintf(stderr, "kernel_launch: occupancy query says %d blocks/CU\n", per_cu);
        (void)hipGetLastError();
        ready = 1;
    }
    if (ready < 0) return;
    Args a{};
    Ctx& c = a.c;
    c.x = (const float*)d_in[0]; c.rel_bias = (const float*)d_in[1]; c.norm_mix_g = (const float*)d_in[2]; c.w_in = (const float*)d_in[3];
    c.pool_w = (const float*)d_in[4]; c.pool_scale = (const float*)d_in[5]; c.w_proj_attn = (const float*)d_in[6]; c.w_proj_pool = (const float*)d_in[7];
    c.w_out = (const float*)d_in[8]; c.norm_ffn_g = (const float*)d_in[9]; c.w_rg = (const float*)d_in[10]; c.w_re = (const float*)d_in[11];
    c.w_gate = (const float*)d_in[12]; c.w_up = (const float*)d_in[13]; c.w_down = (const float*)d_in[14]; c.norm_final_g = (const float*)d_in[15];
    c.out = (float*)d_out; c.ws = (unsigned char*)d_ws;
#if MK_PER_PHASE
    for (int ph = 0; ph < NPHASE; ++ph) { a.ph_lo = ph; a.ph_hi = ph + 1; hipLaunchKernelGGL(mega, dim3(G), dim3(NTHR), LDS_BYTES, stream, a); }
#else
    a.ph_lo = 0; a.ph_hi = NPHASE;
    if (hipMemsetAsync((char*)d_ws + WS_CTL + CT_BAR, 0, CT_BAR_BYTES, stream) != hipSuccess) { fprintf(stderr, "kernel_launch: hipMemsetAsync failed\n"); return; }
    void* args[] = {&a};
    hipError_t e = hipLaunchCooperativeKernel((const void*)mega, dim3(G), dim3(NTHR), args, LDS_BYTES, stream);
    if (e != hipSuccess) fprintf(stderr, "cooperative launch failed: %s\n", hipGetErrorString(e));
#endif
}
```

```cpp
#include <hip/hip_runtime.h>
#include <hip/hip_cooperative_groups.h>
#include <cstdio>
#include <cstdint>

constexpr int NB_ = 8, SEQ = 2048, T = NB_ * SEQ, D = 1024, DEPTH = 2;
constexpr int HD = 64, HPG = 4, NH = 12, AW = 768, AOW = 256;
constexpr int PW = 512, PGW = 128;
constexpr int NIN = 4864, COL_K = 768, COL_V = 1536, COL_U = 2304, COL_G = 2816;
constexpr int NEG = 8, EPG = 8, NE = 64, DE = 512;
constexpr int A2W = AOW + PW;
constexpr int PTILE = 256;
constexpr int PMAX_TILES = T * 2 / PTILE + NE;
constexpr int PMAX = PMAX_TILES * PTILE;
constexpr float EPS = 1e-6f;
constexpr int G = 256;
constexpr int NTHR = 512, NWAVES = 8;

typedef unsigned short bf16_t;
typedef float f32x4 __attribute__((ext_vector_type(4)));
typedef unsigned u32x4 __attribute__((ext_vector_type(4)));
typedef unsigned u32x2 __attribute__((ext_vector_type(2)));
#define LAS __attribute__((address_space(3)))
#define GAS __attribute__((address_space(1)))

constexpr size_t MiB = 1u << 20;
constexpr size_t WS_CTL = 0;
constexpr size_t WS_XN = 1 * MiB;
constexpr size_t WS_PROJ = WS_XN + (size_t)T * D * 2;
constexpr size_t WS_XPAD = WS_PROJ;
constexpr size_t WS_HB = WS_XPAD + (size_t)PMAX * D * 2;
constexpr size_t WS_A2 = WS_PROJ + (size_t)T * NIN * 2;
constexpr size_t WS_Y = WS_A2 + (size_t)T * A2W * 2;
constexpr size_t WS_H = WS_Y + (size_t)T * D * 2;
constexpr size_t WS_YPAD = WS_H + (size_t)T * D * 4;
constexpr size_t WS_Y1 = WS_YPAD;
constexpr size_t WS_OG = WS_XN;
constexpr size_t WS_LSE = WS_OG + (size_t)3 * T * AOW * 2;
constexpr size_t WS_WPC = WS_YPAD + (size_t)PMAX * D * 2;
constexpr size_t WS_END0 = WS_WPC + (size_t)DEPTH * D * PW * 2;
constexpr size_t WS_WIN = WS_END0;
constexpr size_t WS_WP = WS_WIN + (size_t)DEPTH * NIN * D * 2;
constexpr size_t WS_WOUT = WS_WP + (size_t)DEPTH * D * A2W * 2;
constexpr size_t WS_WR = WS_WOUT + (size_t)DEPTH * D * D * 2;
constexpr size_t WS_END = WS_WR + (size_t)DEPTH * 2 * 32 * 5 * 64 * 16;
static_assert(WS_HB + (size_t)PMAX * DE * 2 <= WS_A2, "XPAD+HB alias PROJ");
static_assert((size_t)T * D * 4 <= (size_t)PMAX * D * 2, "Y1 aliases YPAD");
constexpr size_t CT_EID = 0;
constexpr size_t CT_CW = 128 * 1024;
constexpr size_t CT_DEST = 256 * 1024;
constexpr size_t CT_HIST = 384 * 1024;
constexpr size_t CT_TILEE = 448 * 1024;
constexpr size_t CT_META = 450 * 1024;
constexpr size_t CT_BAR = 512 * 1024;
constexpr size_t CT_BAR_BYTES = 24 * 1024;
constexpr size_t CT_PANEL = CT_BAR + 16 * 1024;
constexpr size_t CT_READY = CT_BAR + 14 * 1024;
constexpr size_t CT_RSTD = 576 * 1024;
constexpr size_t CT_RS = 832 * 1024;
constexpr size_t CT_SRC = 640 * 1024;

struct Ctx {
    const float *x, *rel_bias, *norm_mix_g, *w_in, *pool_w, *pool_scale, *w_proj_attn, *w_proj_pool, *w_out, *norm_ffn_g, *w_rg, *w_re, *w_gate, *w_up, *w_down, *norm_final_g;
    float* out;
    unsigned char* ws;
    __device__ __host__ bf16_t* XN() const { return (bf16_t*)(ws + WS_XN); }
    __device__ __host__ bf16_t* PROJ() const { return (bf16_t*)(ws + WS_PROJ); }
    __device__ __host__ bf16_t* HB() const { return (bf16_t*)(ws + WS_HB); }
    __device__ __host__ bf16_t* A2() const { return (bf16_t*)(ws + WS_A2); }
    __device__ __host__ bf16_t* Y() const { return (bf16_t*)(ws + WS_Y); }
    __device__ __host__ bf16_t* H() const { return (bf16_t*)(ws + WS_H); }
    __device__ __host__ float* RSTDM() const { return (float*)(ws + WS_H + (size_t)T * D * 2); }
    __device__ __host__ bf16_t* YPAD() const { return (bf16_t*)(ws + WS_YPAD); }
    __device__ __host__ bf16_t* OG() const { return (bf16_t*)(ws + WS_OG); }
    __device__ __host__ float* LSE() const { return (float*)(ws + WS_LSE); }
    __device__ __host__ bf16_t* WIN() const { return (bf16_t*)(ws + WS_WIN); }
    __device__ __host__ bf16_t* WP() const { return (bf16_t*)(ws + WS_WP); }
    __device__ __host__ bf16_t* WOUT() const { return (bf16_t*)(ws + WS_WOUT); }
    __device__ __host__ bf16_t* WR() const { return (bf16_t*)(ws + WS_WR); }
    __device__ __host__ float* RSTD() const { return (float*)(ws + WS_CTL + CT_RSTD); }
    __device__ __host__ int* SRC() const { return (int*)(ws + WS_CTL + CT_SRC); }
    __device__ __host__ float* RS() const { return (float*)(ws + WS_CTL + CT_RS); }
    __device__ __host__ int* READY() const { return (int*)(ws + WS_CTL + CT_READY); }
    __device__ __host__ int* PANEL() const { return (int*)(ws + WS_CTL + CT_PANEL); }
    __device__ __host__ int* EID() const { return (int*)(ws + WS_CTL + CT_EID); }
    __device__ __host__ float* CW() const { return (float*)(ws + WS_CTL + CT_CW); }
    __device__ __host__ int* DEST() const { return (int*)(ws + WS_CTL + CT_DEST); }
    __device__ __host__ int* HIST() const { return (int*)(ws + WS_CTL + CT_HIST); }
    __device__ __host__ int* TILEE() const { return (int*)(ws + WS_CTL + CT_TILEE); }
    __device__ __host__ int* META() const { return (int*)(ws + WS_CTL + CT_META); }
};

__device__ __forceinline__ float bf2f(bf16_t v) { return __uint_as_float((unsigned)v << 16); }
__device__ __forceinline__ unsigned f2bf(float f) { unsigned u = __float_as_uint(f); return (u + 0x7fffu + ((u >> 16) & 1u)) >> 16; }
typedef float f32x2_t __attribute__((ext_vector_type(2))); typedef __bf16 bf16x2_t __attribute__((ext_vector_type(2)));
__device__ __forceinline__ unsigned pk2(float lo, float hi) { f32x2_t v = {lo, hi}; bf16x2_t b = __builtin_convertvector(v, bf16x2_t); return __builtin_bit_cast(unsigned, b); }
template <int MASK> __device__ __forceinline__ float swz_xor(float v) { return __int_as_float(__builtin_amdgcn_ds_swizzle(__float_as_int(v), (MASK << 10) | 0x1f)); }
__device__ __forceinline__ float sum_x32(float v) {
    const auto r = __builtin_amdgcn_permlane32_swap(__float_as_uint(v), __float_as_uint(v), false, false); return __uint_as_float(r[0]) + __uint_as_float(r[1]); }
__device__ __forceinline__ float max_x32(float v) {
    const auto r = __builtin_amdgcn_permlane32_swap(__float_as_uint(v), __float_as_uint(v), false, false); return fmaxf(__uint_as_float(r[0]), __uint_as_float(r[1])); }
__device__ __forceinline__ float wave_sum(float v) { v += swz_xor<1>(v); v += swz_xor<2>(v); v += swz_xor<4>(v); v += swz_xor<8>(v); v += swz_xor<16>(v); return sum_x32(v); }
__device__ __forceinline__ float wave_max(float v) { v = fmaxf(v, swz_xor<1>(v)); v = fmaxf(v, swz_xor<2>(v)); v = fmaxf(v, swz_xor<4>(v)); v = fmaxf(v, swz_xor<8>(v)); v = fmaxf(v, swz_xor<16>(v)); return max_x32(v); }
__device__ __forceinline__ int opaque_tid(int wv) { int t; asm volatile("v_mbcnt_lo_u32_b32 %0, -1, 0\n\tv_mbcnt_hi_u32_b32 %0, -1, %0" : "=v"(t)); return wv * 64 + t; }
__device__ __forceinline__ float sigmoidf_(float v) { return 1.0f / (1.0f + __expf(-v)); }

__device__ __forceinline__ int t5_bucket(int rel) {
    const int n = rel < 0 ? -rel : rel; const int ret = rel > 0 ? 16 : 0;
    if (n < 8) return ret + n;
    int l = 8; l += (n >= 15); l += (n >= 27); l += (n >= 50); l += (n >= 91); l += (n >= 166); l += (n >= 305); l += (n >= 559);
    return ret + l;
}

__device__ __forceinline__ void ph_norm_rows(const float* src, const float* gain, bf16_t* dst, int vcu, int nb, int wv) {
    const int tid = opaque_tid(wv);
    const int lane = tid & 63, wave = tid >> 6;
    const int gw = vcu * NWAVES + wave, ngw = nb * NWAVES;
    f32x4 gn[4];
#pragma unroll
    for (int j = 0; j < 4; ++j) gn[j] = ((const f32x4*)gain)[lane + 64 * j];
    for (int m0 = gw * 4; m0 < T; m0 += ngw * 4) {
        f32x4 v[4][4];
#pragma unroll
        for (int q = 0; q < 4; ++q)
#pragma unroll
            for (int j = 0; j < 4; ++j) v[q][j] = ((const f32x4*)(src + (size_t)(m0 + q) * D))[lane + 64 * j];
#pragma unroll
        for (int q = 0; q < 4; ++q) {
            float s = 0.f;
#pragma unroll
            for (int j = 0; j < 4; ++j) s += (v[q][j].x * v[q][j].x + v[q][j].y * v[q][j].y) + (v[q][j].z * v[q][j].z + v[q][j].w * v[q][j].w);
            const float r = rsqrtf(wave_sum(s) * (1.f / D) + EPS);
            u32x2* o8 = (u32x2*)(dst + (size_t)(m0 + q) * D) + lane;
#pragma unroll
            for (int j = 0; j < 4; ++j) { u32x2 w; w.x = pk2(v[q][j].x * r * gn[j].x, v[q][j].y * r * gn[j].y); w.y = pk2(v[q][j].z * r * gn[j].z, v[q][j].w * r * gn[j].w); o8[64 * j] = w; }
        }
    }
}


__device__ __forceinline__ void ph_x_to_h(const float* src, bf16_t* dst, float* rs, int vcu, int nb, int wv) {
    const int tid = opaque_tid(wv);
    const int lane = tid & 63, wave = tid >> 6;
    const int gw = vcu * NWAVES + wave, ngw = nb * NWAVES;
    for (int m0 = gw * 4; m0 < T; m0 += ngw * 4) {
        f32x4 v[4][4];
#pragma unroll
        for (int q = 0; q < 4; ++q)
#pragma unroll
            for (int j = 0; j < 4; ++j) v[q][j] = ((const f32x4*)(src + (size_t)(m0 + q) * D))[lane + 64 * j];
#pragma unroll
        for (int q = 0; q < 4; ++q) {
            float s = 0.f;
#pragma unroll
            for (int j = 0; j < 4; ++j) s += (v[q][j].x * v[q][j].x + v[q][j].y * v[q][j].y) + (v[q][j].z * v[q][j].z + v[q][j].w * v[q][j].w);
            const float r = rsqrtf(wave_sum(s) * (1.f / D) + EPS);
            if (lane == 0) rs[m0 + q] = r;
            u32x2* o8 = (u32x2*)(dst + (size_t)(m0 + q) * D) + lane;
#pragma unroll
            for (int j = 0; j < 4; ++j) { u32x2 w; w.x = pk2(v[q][j].x, v[q][j].y); w.y = pk2(v[q][j].z, v[q][j].w); o8[64 * j] = w; }
        }
    }
}

__device__ __forceinline__ void ph_fold_wpc(const Ctx& c, int vcu, int nb, int wv) {
    const int tid = opaque_tid(wv);
    const int lane = tid & 63, wave = __builtin_amdgcn_readfirstlane(tid >> 6);
    const int gw = vcu * NWAVES + wave, ngw = nb * NWAVES;
    for (int it = gw; it < DEPTH * 4 * 16 * 16; it += ngw) {
        const int cc = it & 15, nbk = (it >> 4) & 15, g = (it >> 8) & 3, l = it >> 10;
        const int n = nbk * 64 + lane, c0 = cc * 8;
        const float* pw = c.pool_w + ((size_t)(l * 4 + g) * PGW + c0) * PGW;
        const float* ps = c.pool_scale + (size_t)l * PW + g * PGW;
        const float* wp = c.w_proj_pool + ((size_t)l * PW + g * PGW) * D + n;
        float acc[8];
#pragma unroll
        for (int i = 0; i < 8; ++i) acc[i] = 0.f;
#pragma unroll 2
        for (int e0 = 0; e0 < PGW; e0 += 8) {
            float w[8];
            const f32x4 s0 = *(const f32x4*)(ps + e0), s1 = *(const f32x4*)(ps + e0 + 4);
#pragma unroll
            for (int q = 0; q < 8; ++q) w[q] = wp[(size_t)(e0 + q) * D] * (q < 4 ? s0[q] : s1[q - 4]);
#pragma unroll
            for (int i = 0; i < 8; ++i) { const f32x4 a = *(const f32x4*)(pw + i * PGW + e0), b = *(const f32x4*)(pw + i * PGW + e0 + 4);
                acc[i] += (a.x * w[0] + a.y * w[1]) + (a.z * w[2] + a.w * w[3]) + (b.x * w[4] + b.y * w[5]) + (b.z * w[6] + b.w * w[7]); }
        }
        u32x4 w0; w0.x = pk2(acc[0], acc[1]); w0.y = pk2(acc[2], acc[3]); w0.z = pk2(acc[4], acc[5]); w0.w = pk2(acc[6], acc[7]);
        *(u32x4*)(c.WP() + ((size_t)l * D + n) * A2W + AOW + g * PGW + c0) = w0;
    }
}

typedef short bf16x8_r __attribute__((ext_vector_type(8)));
__device__ __forceinline__ void split8(const f32x4& x0, const f32x4& x1, bf16x8_r& hi, bf16x8_r& lo) {
    u32x4 h, l;
    const unsigned h0 = f2bf(x0.x), h1 = f2bf(x0.y), h2 = f2bf(x0.z), h3 = f2bf(x0.w), h4 = f2bf(x1.x), h5 = f2bf(x1.y), h6 = f2bf(x1.z), h7 = f2bf(x1.w);
    h.x = h0 | (h1 << 16); h.y = h2 | (h3 << 16); h.z = h4 | (h5 << 16); h.w = h6 | (h7 << 16);
    l.x = pk2(x0.x - __uint_as_float(h0 << 16), x0.y - __uint_as_float(h1 << 16)); l.y = pk2(x0.z - __uint_as_float(h2 << 16), x0.w - __uint_as_float(h3 << 16));
    l.z = pk2(x1.x - __uint_as_float(h4 << 16), x1.y - __uint_as_float(h5 << 16)); l.w = pk2(x1.z - __uint_as_float(h6 << 16), x1.w - __uint_as_float(h7 << 16));
    hi = __builtin_bit_cast(bf16x8_r, h); lo = __builtin_bit_cast(bf16x8_r, l);
}
constexpr int WR_FRAGS = 32 * 5 * 64;
__device__ __forceinline__ void ph_router(const Ctx& c, int layer, int vcu, int nb, LAS unsigned char* lds, int wv) {
    const int tid = opaque_tid(wv);
    const int lane = tid & 63, wave = __builtin_amdgcn_readfirstlane(tid >> 6), g = lane >> 4, cq = lane & 15;
    LAS float* slab = (LAS float*)lds;
    LAS float* lss = slab + 4 * 64 * 80;
    LAS int* lhist = (LAS int*)(lss + 256);
    const int t0 = vcu * 64;
    const bf16x8_r* WRh = (const bf16x8_r*)c.WR() + (size_t)layer * 2 * WR_FRAGS; const bf16x8_r* WRl = WRh + WR_FRAGS;
    f32x4 acc[4][5]; float ss[4] = {0.f, 0.f, 0.f, 0.f};
#pragma unroll
    for (int mi = 0; mi < 4; ++mi)
#pragma unroll
        for (int nt = 0; nt < 5; ++nt) acc[mi][nt] = (f32x4){0.f, 0.f, 0.f, 0.f};
    if (tid < NE) lhist[tid] = 0;
#pragma unroll
    for (int ks = 0; ks < 4; ++ks) {
        const int kk = 4 * wave + ks;
        bf16x8_r bh[5], bl[5];
#pragma unroll
        for (int nt = 0; nt < 5; ++nt) { bh[nt] = WRh[(kk * 5 + nt) * 64 + lane]; bl[nt] = WRl[(kk * 5 + nt) * 64 + lane]; }
#pragma unroll
        for (int mi = 0; mi < 4; ++mi) {
            const u32x4 hx = *(const u32x4*)(c.H() + (size_t)(t0 + 16 * mi + cq) * D + 32 * kk + 8 * g);
            f32x4 x0, x1;
            x0.x = __uint_as_float(hx.x << 16); x0.y = __uint_as_float(hx.x & 0xffff0000u); x0.z = __uint_as_float(hx.y << 16); x0.w = __uint_as_float(hx.y & 0xffff0000u);
            x1.x = __uint_as_float(hx.z << 16); x1.y = __uint_as_float(hx.z & 0xffff0000u); x1.z = __uint_as_float(hx.w << 16); x1.w = __uint_as_float(hx.w & 0xffff0000u);
            ss[mi] += (x0.x * x0.x + x0.y * x0.y) + (x0.z * x0.z + x0.w * x0.w) + (x1.x * x1.x + x1.y * x1.y) + (x1.z * x1.z + x1.w * x1.w);
            const bf16x8_r ah = __builtin_bit_cast(bf16x8_r, hx);
#pragma unroll
            for (int nt = 0; nt < 5; ++nt) {
                acc[mi][nt] = __builtin_amdgcn_mfma_f32_16x16x32_bf16(ah, bh[nt], acc[mi][nt], 0, 0, 0);
                acc[mi][nt] = __builtin_amdgcn_mfma_f32_16x16x32_bf16(ah, bl[nt], acc[mi][nt], 0, 0, 0);
            }
        }
    }
    LAS float* myslab = slab + (wave & 3) * 64 * 80;
#pragma unroll
    for (int mi = 0; mi < 4; ++mi) { float sv = ss[mi]; sv += swz_xor<16>(sv); ss[mi] = sum_x32(sv); }
    if (wave < 4) {
#pragma unroll
        for (int mi = 0; mi < 4; ++mi) {
#pragma unroll
            for (int nt = 0; nt < 5; ++nt)
#pragma unroll
                for (int j = 0; j < 4; ++j) myslab[(16 * mi + 4 * g + j) * 80 + 16 * nt + cq] = acc[mi][nt][j];
            if (g == 0) lss[(wave & 3) * 64 + 16 * mi + cq] = ss[mi];
        }
    }
    __syncthreads();
    if (wave >= 4) {
#pragma unroll
        for (int mi = 0; mi < 4; ++mi) {
#pragma unroll
            for (int nt = 0; nt < 5; ++nt)
#pragma unroll
                for (int j = 0; j < 4; ++j) myslab[(16 * mi + 4 * g + j) * 80 + 16 * nt + cq] += acc[mi][nt][j];
            if (g == 0) lss[(wave & 3) * 64 + 16 * mi + cq] += ss[mi];
        }
    }
    __syncthreads();
    if (tid < 64) {
        const int t = t0 + tid;
        const float r = rsqrtf(((lss[tid] + lss[64 + tid]) + (lss[128 + tid] + lss[192 + tid])) * (1.f / D) + EPS);
        LAS const float* s0 = slab + tid * 80;
        float a[8];
#pragma unroll
        for (int q = 0; q < 8; ++q) a[q] = ((s0[q] + s0[5120 + q]) + (s0[10240 + q] + s0[15360 + q])) * r;
        int gi = 0; float lmax = a[0];
#pragma unroll
        for (int q = 1; q < 8; ++q) if (a[q] > lmax) { lmax = a[q]; gi = q; }
        float se = 0.f;
#pragma unroll
        for (int q = 0; q < 8; ++q) se += __expf(a[q] - lmax);
        const float gp = 1.0f / se;
        float bq[8];
#pragma unroll
        for (int q = 0; q < 8; ++q) { const int n = 8 + gi * 8 + q; bq[q] = ((s0[n] + s0[5120 + n]) + (s0[10240 + n] + s0[15360 + n])) * r; }
        int i0 = 0; float v0 = bq[0];
#pragma unroll
        for (int q = 1; q < 8; ++q) if (bq[q] > v0) { v0 = bq[q]; i0 = q; }
        int i1 = -1; float v1 = -3.0e38f;
#pragma unroll
        for (int q = 0; q < 8; ++q) if (q != i0 && bq[q] > v1) { v1 = bq[q]; i1 = q; }
        const float e1 = __expf(v1 - v0), p0 = 1.0f / (1.0f + e1), p1 = e1 * p0;
        const int ea = gi * EPG + i0, eb = gi * EPG + i1;
        c.EID()[2 * t] = ea; c.EID()[2 * t + 1] = eb;
        c.CW()[2 * t] = gp * p0; c.CW()[2 * t + 1] = gp * p1;
        c.RSTD()[t] = r;
        __hip_atomic_fetch_add(&lhist[ea], 1, __ATOMIC_RELAXED, __HIP_MEMORY_SCOPE_WORKGROUP); __hip_atomic_fetch_add(&lhist[eb], 1, __ATOMIC_RELAXED, __HIP_MEMORY_SCOPE_WORKGROUP);
    }
    __syncthreads();
    if (tid < NE) c.HIST()[vcu * NE + tid] = lhist[tid];
    for (int i = vcu * NTHR + tid; i < PMAX; i += nb * NTHR) c.SRC()[i] = 0;
}


__device__ __forceinline__ void ph_scatter(const Ctx& c, int layer, int vcu, int nb, LAS int* lds, int wv) {
    const int tid = opaque_tid(wv);
    const int lane = tid & 63, wave = tid >> 6;
    const int TPB = T / nb, NA = 2 * TPB;
    LAS int* l_cnt = lds; LAS int* l_base = lds + 64; LAS int* l_poff = lds + 128; LAS int* l_eid = lds + 192; LAS int* l_dest = lds + 192 + NA; LAS int* l_pt = lds + 192 + 2 * NA; LAS int* l_pb = l_pt + 512;
    {
        const int e = tid & 63, part = tid >> 6, bper = nb / 8;
        int tot = 0, base = 0;
#pragma unroll 8
        for (int i = 0; i < bper; ++i) { const int b = part * bper + i; const int hv = c.HIST()[b * NE + e]; tot += hv; base += (b < vcu) ? hv : 0; }
        l_pt[part * 64 + e] = tot; l_pb[part * 64 + e] = base;
    }
    for (int a = tid; a < NA; a += NTHR) l_eid[a] = c.EID()[vcu * NA + a];
    __syncthreads();
    int my_nt = 0;
    if (tid < NE) { int tot = 0, base = 0;
#pragma unroll
        for (int p = 0; p < 8; ++p) { tot += l_pt[p * 64 + tid]; base += l_pb[p * 64 + tid]; }
        my_nt = (tot + PTILE - 1) / PTILE;
        l_cnt[tid] = my_nt; l_base[tid] = base; l_pt[tid] = 0; }
    __syncthreads();
    if (tid < NE) {
        int off = 0;
#pragma unroll
        for (int e = 0; e < NE; ++e) { const int v = l_cnt[e]; off += (e < tid) ? v : 0; }
        l_poff[tid] = off * PTILE;
        if (vcu == 0) { for (int i = 0; i < my_nt; ++i) c.TILEE()[off + i] = tid; if (tid == NE - 1) c.META()[0] = off + my_nt; }
    }
    __syncthreads();
    for (int a = tid; a < NA; a += NTHR) {
        const int e = l_eid[a];
        const int rank = __hip_atomic_fetch_add(&l_pt[e], 1, __ATOMIC_RELAXED, __HIP_MEMORY_SCOPE_WORKGROUP);
        const int dst = l_poff[e] + l_base[e] + rank;
        l_dest[a] = dst; c.DEST()[vcu * NA + a] = dst;
    }
    __syncthreads();
    for (int a = tid; a < NA; a += NTHR) { const int t = vcu * TPB + (a >> 1); c.SRC()[l_dest[a]] = t; c.RS()[l_dest[a]] = c.RSTD()[t]; }
}

__device__ __forceinline__ void ph_combine(const Ctx& c, int layer, int vcu, int nb, int wv) {
    const int tid = opaque_tid(wv);
    const int lane = tid & 63, wave = tid >> 6;
    const int gw = vcu * NWAVES + wave, ngw = nb * NWAVES;
    const bool last = (layer == DEPTH - 1);
    const float* gain = last ? c.norm_final_g : c.norm_mix_g + (size_t)(layer + 1) * D;
    f32x4 gn[4];
#pragma unroll
    for (int j = 0; j < 4; ++j) gn[j] = ((const f32x4*)gain)[lane + 64 * j];
    const int tpb = T / nb;
    for (int t0 = vcu * tpb + wave * 4; t0 < (vcu + 1) * tpb; t0 += NWAVES * 4) {
        int d0[4], d1[4]; float w0[4], w1[4];
#pragma unroll
        for (int q = 0; q < 4; ++q) { d0[q] = c.DEST()[2 * (t0 + q)]; d1[q] = c.DEST()[2 * (t0 + q) + 1]; w0[q] = c.CW()[2 * (t0 + q)]; w1[q] = c.CW()[2 * (t0 + q) + 1]; }
        f32x4 h[4][4]; u32x2 ya[4][4], yb[4][4];
#pragma unroll
        for (int q = 0; q < 4; ++q)
#pragma unroll
            for (int j = 0; j < 4; ++j) {
                { const u32x2 hv = ((const u32x2*)(c.H() + (size_t)(t0 + q) * D))[lane + 64 * j];
                  h[q][j].x = __uint_as_float(hv.x << 16); h[q][j].y = __uint_as_float(hv.x & 0xffff0000u); h[q][j].z = __uint_as_float(hv.y << 16); h[q][j].w = __uint_as_float(hv.y & 0xffff0000u); }
                ya[q][j] = ((const u32x2*)(c.YPAD() + (size_t)d0[q] * D))[lane + 64 * j];
                yb[q][j] = ((const u32x2*)(c.YPAD() + (size_t)d1[q] * D))[lane + 64 * j];
            }
#pragma unroll
        for (int q = 0; q < 4; ++q) {
            float s = 0.f;
#pragma unroll
            for (int j = 0; j < 4; ++j) {
                const u32x2 a = ya[q][j], b = yb[q][j]; f32x4 o = h[q][j];
                o.x += w0[q] * __uint_as_float(a.x << 16) + w1[q] * __uint_as_float(b.x << 16);
                o.y += w0[q] * __uint_as_float(a.x & 0xffff0000u) + w1[q] * __uint_as_float(b.x & 0xffff0000u);
                o.z += w0[q] * __uint_as_float(a.y << 16) + w1[q] * __uint_as_float(b.y << 16);
                o.w += w0[q] * __uint_as_float(a.y & 0xffff0000u) + w1[q] * __uint_as_float(b.y & 0xffff0000u);
                h[q][j] = o; s += (o.x * o.x + o.y * o.y) + (o.z * o.z + o.w * o.w);
            }
            const float r = rsqrtf(wave_sum(s) * (1.f / D) + EPS);
            if (!last) {
                u32x2* hw = (u32x2*)(c.H() + (size_t)(t0 + q) * D) + lane;
#pragma unroll
                for (int j = 0; j < 4; ++j) { u32x2 hv; hv.x = pk2(h[q][j].x, h[q][j].y); hv.y = pk2(h[q][j].z, h[q][j].w); hw[64 * j] = hv; }
                if (lane == 0) c.RSTDM()[t0 + q] = r;
            } else {
                f32x4* o = (f32x4*)(c.out + (size_t)(t0 + q) * D) + lane;
#pragma unroll
                for (int j = 0; j < 4; ++j) { f32x4 w; w.x = h[q][j].x * r * gn[j].x; w.y = h[q][j].y * r * gn[j].y; w.z = h[q][j].z * r * gn[j].z; w.w = h[q][j].w * r * gn[j].w; o[64 * j] = w; }
            }
        }
    }
}


__device__ __forceinline__ void unpack8(const u32x4 w, float (&f)[8]) {
    f[0] = __uint_as_float(w.x << 16); f[1] = __uint_as_float(w.x & 0xffff0000u); f[2] = __uint_as_float(w.y << 16); f[3] = __uint_as_float(w.y & 0xffff0000u);
    f[4] = __uint_as_float(w.z << 16); f[5] = __uint_as_float(w.z & 0xffff0000u); f[6] = __uint_as_float(w.w << 16); f[7] = __uint_as_float(w.w & 0xffff0000u);
}
__device__ __forceinline__ void ph_pool(const Ctx& c, int vcu, int nb, LAS unsigned char* lds, int wv) {
    const int tid = opaque_tid(wv);
    const bf16_t* P = c.PROJ();
    const int cg = tid & 63, tq = tid >> 6, hw = 1 << (cg >> 4);
    for (int tile = vcu; tile < T / 64; tile += nb) {
        const int t0 = tile * 64, b = t0 / SEQ, i0 = t0 % SEQ;
        __syncthreads();
#pragma unroll
        for (int k = 0; k < 10; ++k) {
            const int idx = tid + NTHR * k, row = idx >> 6, ch = idx & 63, pos = i0 - 8 + row;
            u32x4 v = {0u, 0u, 0u, 0u};
            if (pos >= 0 && pos < SEQ) v = *(const u32x4*)(P + (size_t)(b * SEQ + pos) * NIN + COL_U + ch * 8);
            *(LAS u32x4*)(lds + row * 1024 + ch * 16) = v;
        }
        __syncthreads();
        LAS const unsigned char* col = lds + cg * 16;
        const int r0 = 8 * tq + 8;
        float S[8], f[8];
#pragma unroll
        for (int e = 0; e < 8; ++e) S[e] = 0.f;
#pragma unroll
        for (int q = 0; q < 16; ++q) {
            unpack8(*(LAS const u32x4*)(col + (r0 - hw + q) * 1024), f);
            const float on = (q < 2 * hw) ? 1.f : 0.f;
#pragma unroll
            for (int e = 0; e < 8; ++e) S[e] += on * f[e];
        }
        bf16_t* outp = c.A2() + (size_t)(t0 + 8 * tq) * A2W + AOW + 8 * cg;
#pragma unroll
        for (int jt = 0; jt < 8; ++jt) {
            const int pos = i0 + 8 * tq + jt, lo = max(pos - hw, 0), hi = min(pos + hw, SEQ);
            const float inv = 1.0f / (float)(hi - lo);
            unpack8(*(LAS const u32x4*)(col + (r0 + jt) * 1024), f);
            u32x4 w; w.x = pk2(S[0] * inv - f[0], S[1] * inv - f[1]); w.y = pk2(S[2] * inv - f[2], S[3] * inv - f[3]); w.z = pk2(S[4] * inv - f[4], S[5] * inv - f[5]); w.w = pk2(S[6] * inv - f[6], S[7] * inv - f[7]);
            *(u32x4*)(outp + (size_t)jt * A2W) = w;
            if (jt < 7) {
                float a[8], d[8]; unpack8(*(LAS const u32x4*)(col + (r0 + jt + hw) * 1024), a); unpack8(*(LAS const u32x4*)(col + (r0 + jt - hw) * 1024), d);
#pragma unroll
                for (int e = 0; e < 8; ++e) S[e] += a[e] - d[e];
            }
        }
    }
}

typedef short bf16x8_t __attribute__((ext_vector_type(8)));
typedef short s16x4_t __attribute__((ext_vector_type(4)));
constexpr int AT_ROWB = 160;
constexpr int AT_KOFF = 0, AT_VOFF = 192 * AT_ROWB, AT_BIAS = 2 * 192 * AT_ROWB, AT_SLOT = AT_BIAS + 1024;
constexpr int NUNITS = NB_ * 3 * HPG * 32;
static_assert(2 * AT_SLOT <= 131072, "attention LDS");
__device__ __forceinline__ s16x4_t lds_tr16(LAS const unsigned char* p) { return __builtin_bit_cast(s16x4_t, __builtin_amdgcn_ds_read_tr16_b64_v4i16((LAS s16x4_t*)p)); }

struct AttnUnit { size_t tok0; int dil, L, blk, nblk, gi, hh, head; };
__device__ __forceinline__ AttnUnit attn_decode(int u) {
    AttnUnit a; const int b = u / 384, rem = u % 384; a.gi = rem >> 7; a.hh = (rem >> 5) & 3; const int rb = rem & 31;
    const int dsh = 2 * a.gi; a.dil = 1 << dsh; a.L = SEQ >> dsh; a.nblk = a.L >> 6;
    const int r = rb / a.nblk; a.blk = rb % a.nblk; a.head = a.gi * HPG + a.hh; a.tok0 = (size_t)b * SEQ + r; return a;
}
__device__ __forceinline__ void ph_attention(const Ctx& c, int vcu, int nb, LAS unsigned char* lds, int wv) {
    const int tid = opaque_tid(wv);
    const int wave = __builtin_amdgcn_readfirstlane(tid >> 6), lane = tid & 63, half = wave >> 2, wq = wave & 3, ht = tid & 255;
    const int g = lane >> 4, cq = lane & 15;
    LAS unsigned char* slot = lds + half * AT_SLOT;
    LAS float* lbias = (LAS float*)(slot + AT_BIAS);
    const bf16_t* P = c.PROJ();
    constexpr float LOG2E = 1.4426950408889634f, QSC = 0.125f * LOG2E;
    u32x4 rk[6], rv[6]; bf16x8_t rq0, rq1; float rb = 0.f;
    AttnUnit un = attn_decode(0);
    auto issue = [&](const AttnUnit& a) {
#pragma unroll
        for (int i = 0; i < 6; ++i) {
            const int idx = ht + 256 * i, row = idx >> 3, ch = idx & 7, lk = 64 * a.blk - 64 + row;
            rk[i] = (u32x4){0u, 0u, 0u, 0u}; rv[i] = (u32x4){0u, 0u, 0u, 0u};
            if (lk >= 0 && lk < a.L) { const bf16_t* rp = P + (a.tok0 + (size_t)a.dil * lk) * NIN + a.head * HD + ch * 8; rk[i] = *(const u32x4*)(rp + COL_K); rv[i] = *(const u32x4*)(rp + COL_V); }
        }
        { const bf16_t* qp = P + (a.tok0 + (size_t)a.dil * (64 * a.blk + 16 * wq + cq)) * NIN + a.head * HD + 8 * g; rq0 = *(const bf16x8_t*)qp; rq1 = *(const bf16x8_t*)(qp + 32); }
        if (ht < 160) { const int rel = ht - 80; rb = (rel >= -64 && rel <= 64) ? c.rel_bias[t5_bucket(a.dil * rel) * NH + a.head] * LOG2E : -1e30f; }
    };
    const bool bl_ = (nb == 256);
    auto pair_of = [&](int it) -> int { return bl_ ? ((it < 6) ? (vcu >> 5) * 192 + it * 32 + (vcu & 31) : NUNITS) : it * nb + vcu; };
    if (pair_of(0) * 2 < NUNITS) { un = attn_decode(pair_of(0) * 2 + half); issue(un); }
    for (int it = 0;; ++it) {
        const int pair = pair_of(it);
        if (pair * 2 >= NUNITS) break;
        const AttnUnit a = un;
#pragma unroll
        for (int i = 0; i < 6; ++i) {
            const int idx = ht + 256 * i, row = idx >> 3, ch = idx & 7;
            *(LAS u32x4*)(slot + AT_KOFF + row * AT_ROWB + ch * 16) = rk[i];
            *(LAS u32x4*)(slot + AT_VOFF + row * AT_ROWB + ch * 16) = rv[i];
        }
        if (ht < 160) lbias[ht] = rb;
        const bf16x8_t qf0 = rq0, qf1 = rq1;
        __syncthreads();
        { const int np = pair_of(it + 1); if (np * 2 < NUNITS) { un = attn_decode(np * 2 + half); issue(un); } }
        f32x4 sc[9];
#pragma unroll
        for (int t = 0; t < 9; ++t) {
            LAS const unsigned char* kp = slot + AT_KOFF + (16 * (wq + t) + cq) * AT_ROWB + 16 * g;
            const bf16x8_t a0 = *(LAS const bf16x8_t*)kp, a1 = *(LAS const bf16x8_t*)(kp + 64);
            f32x4 z = {0.f, 0.f, 0.f, 0.f};
            z = __builtin_amdgcn_mfma_f32_16x16x32_bf16(a0, qf0, z, 0, 0, 0);
            sc[t] = __builtin_amdgcn_mfma_f32_16x16x32_bf16(a1, qf1, z, 0, 0, 0);
        }
        LAS const float* bl = lbias + (16 + 4 * g - cq);
        float m = -1e30f;
#pragma unroll
        for (int t = 0; t < 9; ++t) {
            const bool dead = (a.blk == 0 && wq + t < 4) || (a.blk == a.nblk - 1 && wq + t >= 8);
#pragma unroll
            for (int j = 0; j < 4; ++j) { float v = sc[t][j] * QSC + bl[16 * t + j]; v = dead ? -1e30f : v; sc[t][j] = v; m = fmaxf(m, v); }
        }
        m = fmaxf(m, swz_xor<16>(m)); m = max_x32(m);
        float den = 0.f;
#pragma unroll
        for (int t = 0; t < 9; ++t)
#pragma unroll
            for (int j = 0; j < 4; ++j) { const float p = __builtin_amdgcn_exp2f(sc[t][j] - m); sc[t][j] = p; den += p; }
        den += swz_xor<16>(den); den = sum_x32(den);
        f32x4 o[4];
#pragma unroll
        for (int dt = 0; dt < 4; ++dt) o[dt] = (f32x4){0.f, 0.f, 0.f, 0.f};
#pragma unroll
        for (int ks = 0; ks < 5; ++ks) {
            const int t0 = 2 * ks, t1 = (2 * ks + 1 < 9) ? 2 * ks + 1 : 2 * ks;
            u32x4 pw;
            pw.x = pk2(sc[t0][0], sc[t0][1]); pw.y = pk2(sc[t0][2], sc[t0][3]);
            if (2 * ks + 1 < 9) { pw.z = pk2(sc[t1][0], sc[t1][1]); pw.w = pk2(sc[t1][2], sc[t1][3]); } else { pw.z = 0u; pw.w = 0u; }
            const bf16x8_t pa = __builtin_bit_cast(bf16x8_t, pw);
            LAS const unsigned char* v0 = slot + AT_VOFF + (16 * (wq + t0) + 4 * g + (cq >> 2)) * AT_ROWB + 8 * (cq & 3);
            LAS const unsigned char* v1 = slot + AT_VOFF + (16 * (wq + t1) + 4 * g + (cq >> 2)) * AT_ROWB + 8 * (cq & 3);
#pragma unroll
            for (int dt = 0; dt < 4; ++dt) {
                const s16x4_t b0 = lds_tr16(v0 + 32 * dt), b1 = lds_tr16(v1 + 32 * dt);
                const bf16x8_t bb = __builtin_shufflevector(b0, b1, 0, 1, 2, 3, 4, 5, 6, 7);
                o[dt] = __builtin_amdgcn_mfma_f32_16x16x32_bf16(pa, bb, o[dt], 0, 0, 0);
            }
        }
        bf16_t* og = c.OG() + (size_t)a.gi * T * AOW;
        const int lq0 = 64 * a.blk + 16 * wq;
#pragma unroll
        for (int j = 0; j < 4; ++j) {
            const float inv = __builtin_amdgcn_rcpf(__int_as_float(__builtin_amdgcn_ds_bpermute((4 * g + j) << 2, __float_as_int(den))));
            bf16_t* op = og + (a.tok0 + (size_t)a.dil * (lq0 + 4 * g + j)) * AOW + a.hh * HD + cq;
            const unsigned w01 = pk2(o[0][j] * inv, o[1][j] * inv), w23 = pk2(o[2][j] * inv, o[3][j] * inv);
            op[0] = (bf16_t)(w01 & 0xffffu); op[16] = (bf16_t)(w01 >> 16); op[32] = (bf16_t)(w23 & 0xffffu); op[48] = (bf16_t)(w23 >> 16);
        }
        if (g == 0) c.LSE()[((size_t)a.gi * T + a.tok0 + (size_t)a.dil * (lq0 + cq)) * HPG + a.hh] = (m + __builtin_amdgcn_logf(den)) * 0.6931471805599453f;
        __syncthreads();
    }
}
__device__ __forceinline__ void ph_merge64(const Ctx& c, int t_lo, int wv) {
    const int tid = opaque_tid(wv);
    const unsigned long long ab_u = (unsigned long long)(uintptr_t)c.A2();
    const unsigned ab_lo = (unsigned)__builtin_amdgcn_readfirstlane((unsigned)ab_u), ab_hi = (unsigned)__builtin_amdgcn_readfirstlane((unsigned)(ab_u >> 32));
    const __amdgpu_buffer_rsrc_t ars = __builtin_amdgcn_make_buffer_rsrc((void*)(uintptr_t)(((unsigned long long)ab_hi << 32) | ab_lo), (short)0, (int)((size_t)T * A2W * 2), 0x00020000);
#pragma unroll
    for (int it = 0; it < 4; ++it) {
        const int idx = it * NTHR + tid;
        const int t = t_lo + (idx >> 5), ch = idx & 31, hh = ch >> 3;
        const float l0 = c.LSE()[((size_t)0 * T + t) * HPG + hh], l1 = c.LSE()[((size_t)1 * T + t) * HPG + hh], l2 = c.LSE()[((size_t)2 * T + t) * HPG + hh];
        const float mm = fmaxf(fmaxf(l0, l1), l2);
        float e0 = __expf(l0 - mm), e1 = __expf(l1 - mm), e2 = __expf(l2 - mm);
        const float inv = 1.0f / (e0 + e1 + e2); e0 *= inv; e1 *= inv; e2 *= inv;
        const u32x4 a = *(const u32x4*)(c.OG() + ((size_t)0 * T + t) * AOW + ch * 8), b = *(const u32x4*)(c.OG() + ((size_t)1 * T + t) * AOW + ch * 8), d = *(const u32x4*)(c.OG() + ((size_t)2 * T + t) * AOW + ch * 8);
        u32x4 w;
        w.x = pk2(e0 * __uint_as_float(a.x << 16) + e1 * __uint_as_float(b.x << 16) + e2 * __uint_as_float(d.x << 16), e0 * __uint_as_float(a.x & 0xffff0000u) + e1 * __uint_as_float(b.x & 0xffff0000u) + e2 * __uint_as_float(d.x & 0xffff0000u));
        w.y = pk2(e0 * __uint_as_float(a.y << 16) + e1 * __uint_as_float(b.y << 16) + e2 * __uint_as_float(d.y << 16), e0 * __uint_as_float(a.y & 0xffff0000u) + e1 * __uint_as_float(b.y & 0xffff0000u) + e2 * __uint_as_float(d.y & 0xffff0000u));
        w.z = pk2(e0 * __uint_as_float(a.z << 16) + e1 * __uint_as_float(b.z << 16) + e2 * __uint_as_float(d.z << 16), e0 * __uint_as_float(a.z & 0xffff0000u) + e1 * __uint_as_float(b.z & 0xffff0000u) + e2 * __uint_as_float(d.z & 0xffff0000u));
        w.w = pk2(e0 * __uint_as_float(a.w << 16) + e1 * __uint_as_float(b.w << 16) + e2 * __uint_as_float(d.w << 16), e0 * __uint_as_float(a.w & 0xffff0000u) + e1 * __uint_as_float(b.w & 0xffff0000u) + e2 * __uint_as_float(d.w & 0xffff0000u));
        __builtin_amdgcn_raw_buffer_store_b128(w, ars, (int)(((unsigned)t * A2W + ch * 8) * 2u), 0, 16);
    }
}

namespace pg8 {
#define PG8_LAS __attribute__((address_space(3)))
typedef unsigned short bf16_t;
typedef short bf16x8 __attribute__((ext_vector_type(8)));
typedef float f32x4 __attribute__((ext_vector_type(4)));
typedef unsigned u32x4 __attribute__((ext_vector_type(4)));
constexpr int BM = 256, BK = 64, HALF = 128, HTB = HALF * BK * 2  , STAGE_BYTES = 8 * HTB, NXCD = 8, WGM = 8;

__host__ __device__ __forceinline__ int lds_byte(int r, int c) { const int st = (r >> 4) * 2 + (c >> 5), rr = r & 15, cc = c & 31, ob = rr * 64 + cc * 2; return st * 1024 + (ob ^ (((ob >> 9) & 1) << 5)); }
__host__ __device__ __forceinline__ void stage_rc(int b, int& R, int& C) { const int st = b / 1024, sb = b % 1024, swz = sb ^ (((sb >> 9) & 1) << 5); R = (st >> 1) * 16 + swz / 64; C = (st & 1) * 32 + (swz % 64) / 2; }
__host__ __device__ __forceinline__ int perm32(int rho) { const int n = rho >> 4, i = rho & 15; return 8 * (i >> 2) + 4 * n + (i & 3); }

struct Unit { int pm, pn, pb; };
struct Gemm { const bf16_t* A; const bf16_t* Bt; int M, N, K; };

struct StaticOrder {
    int nM, nN, nwg, G, c;
    __host__ __device__ void init(int M, int N, int G_, int c_) { nM = M / BM; nN = N / BM; nwg = nM * nN; G = G_; c = c_; }
    __host__ __device__ bool next(int i, Unit& u) const {
        const long L = (long)i * G + c; if (L >= nwg) return false;
        int wgid = (int)L; { const int q = nwg / NXCD, r = nwg % NXCD, xcd = wgid % NXCD, off = wgid / NXCD; wgid = (xcd < r ? xcd * (q + 1) : r * (q + 1) + (xcd - r) * q) + off; }
        const int nig = WGM * nN, gid = wgid / nig, fm = gid * WGM, gsz = (nM - fm) < WGM ? (nM - fm) : WGM;
        u.pm = fm + ((wgid % nig) % gsz); u.pn = (wgid % nig) / gsz; u.pb = u.pn; return true;
    }
    __device__ __forceinline__ void a_ready(const Unit&) const {}
    __device__ __forceinline__ void done(const Unit&) const {}
};


__device__ __forceinline__ unsigned cvt_pk_bf16(float lo, float hi) { unsigned r; asm volatile("v_cvt_pk_bf16_f32 %0, %1, %2" : "=v"(r) : "v"(lo), "v"(hi)); return r; }
__device__ __forceinline__ float bflo(unsigned w) { return __uint_as_float(w << 16); }
__device__ __forceinline__ float bfhi(unsigned w) { return __uint_as_float(w & 0xffff0000u); }
__device__ __forceinline__ float fsig(float v) { return __builtin_amdgcn_rcpf(1.0f + __expf(-v)); }
__device__ __forceinline__ u32x4 pack8(const f32x4& a, const f32x4& b) { u32x4 w; w.x = cvt_pk_bf16(a[0], a[1]); w.y = cvt_pk_bf16(a[2], a[3]); w.z = cvt_pk_bf16(b[0], b[1]); w.w = cvt_pk_bf16(b[2], b[3]); return w; }

struct EpiProj {
    static constexpr bool PERM = true, AFTER_DRAIN = false; static constexpr int MID_T = 0;
    bf16_t* P; const float* rs;
    __device__ __forceinline__ void mid(f32x4 (&)[2][2][4][2], const Unit&, int, int, int, int) const {}
    __device__ __forceinline__ void operator()(const f32x4 (&acc)[2][2][4][2], const Unit& u, int wr, int wc, int fr, int fq) const {
        const int row0 = u.pm * BM + wr * 64 + fr, col0 = u.pn * BM + wc * 32 + 8 * fq; const bool gate = (u.pn * BM >= COL_G);
        float rv[2][4];
#pragma unroll
        for (int ai = 0; ai < 2; ++ai)
#pragma unroll
            for (int m = 0; m < 4; ++m) rv[ai][m] = rs[row0 + ai * HALF + m * 16];
#pragma unroll
        for (int ai = 0; ai < 2; ++ai)
#pragma unroll
            for (int m = 0; m < 4; ++m) { bf16_t* rowp = P + (size_t)(row0 + ai * HALF + m * 16) * NIN + col0;
#pragma unroll
                for (int bj = 0; bj < 2; ++bj) { f32x4 v0 = acc[ai][bj][m][0] * rv[ai][m], v1 = acc[ai][bj][m][1] * rv[ai][m];
                    if (gate) {
#pragma unroll
                        for (int i = 0; i < 4; ++i) { v0[i] = fsig(v0[i]); v1[i] = fsig(v1[i]); } }
                    *(u32x4*)(rowp + bj * HALF) = pack8(v0, v1); } }
    }
};
struct EpiGate {
    static constexpr bool PERM = true, AFTER_DRAIN = false; static constexpr int MID_T = AOW / BK;
    const bf16_t* P; bf16_t* Y;
    __device__ __forceinline__ void mid(f32x4 (&acc)[2][2][4][2], const Unit& u, int wr, int wc, int fr, int fq) const {
        int row0 = u.pm * BM + wr * 64 + fr, col0 = u.pn * BM + wc * 32 + 8 * fq;
        asm volatile("" : "+v"(row0), "+v"(col0));
#pragma unroll
        for (int ai = 0; ai < 2; ++ai) {
            u32x4 ga[4][2], gb[4][2];
#pragma unroll
            for (int m = 0; m < 4; ++m) { const bf16_t* gp = P + (size_t)(row0 + ai * HALF + m * 16) * NIN + COL_G + col0;
#pragma unroll
                for (int bj = 0; bj < 2; ++bj) { ga[m][bj] = *(const u32x4*)(gp + bj * HALF); gb[m][bj] = *(const u32x4*)(gp + D + bj * HALF); } }
#pragma unroll
            for (int m = 0; m < 4; ++m)
#pragma unroll
                for (int bj = 0; bj < 2; ++bj) { const u32x4 a = ga[m][bj], b = gb[m][bj];
                    f32x4& v0 = acc[ai][bj][m][0]; f32x4& v1 = acc[ai][bj][m][1];
                    v0[0] *= bflo(a.x) * __builtin_amdgcn_rcpf(fmaxf(bflo(b.x), 1e-30f)); v0[1] *= bfhi(a.x) * __builtin_amdgcn_rcpf(fmaxf(bfhi(b.x), 1e-30f));
                    v0[2] *= bflo(a.y) * __builtin_amdgcn_rcpf(fmaxf(bflo(b.y), 1e-30f)); v0[3] *= bfhi(a.y) * __builtin_amdgcn_rcpf(fmaxf(bfhi(b.y), 1e-30f));
                    v1[0] *= bflo(a.z) * __builtin_amdgcn_rcpf(fmaxf(bflo(b.z), 1e-30f)); v1[1] *= bfhi(a.z) * __builtin_amdgcn_rcpf(fmaxf(bfhi(b.z), 1e-30f));
                    v1[2] *= bflo(a.w) * __builtin_amdgcn_rcpf(fmaxf(bflo(b.w), 1e-30f)); v1[3] *= bfhi(a.w) * __builtin_amdgcn_rcpf(fmaxf(bfhi(b.w), 1e-30f)); }
            asm volatile("" ::: "memory"); }
    }
    __device__ __forceinline__ void operator()(const f32x4 (&acc)[2][2][4][2], const Unit& u, int wr, int wc, int fr, int fq) const {
        const int row0 = u.pm * BM + wr * 64 + fr, col0 = u.pn * BM + wc * 32 + 8 * fq;
#pragma unroll
        for (int ai = 0; ai < 2; ++ai) {
            u32x4 gb[4][2];
#pragma unroll
            for (int m = 0; m < 4; ++m)
#pragma unroll
                for (int bj = 0; bj < 2; ++bj) gb[m][bj] = *(const u32x4*)(P + (size_t)(row0 + ai * HALF + m * 16) * NIN + COL_G + D + col0 + bj * HALF);
#pragma unroll
            for (int m = 0; m < 4; ++m) { bf16_t* yp = Y + (size_t)(row0 + ai * HALF + m * 16) * D + col0;
#pragma unroll
                for (int bj = 0; bj < 2; ++bj) { const u32x4 b = gb[m][bj]; f32x4 v0 = acc[ai][bj][m][0], v1 = acc[ai][bj][m][1];
                    v0[0] *= bflo(b.x); v0[1] *= bfhi(b.x); v0[2] *= bflo(b.y); v0[3] *= bfhi(b.y); v1[0] *= bflo(b.z); v1[1] *= bfhi(b.z); v1[2] *= bflo(b.w); v1[3] *= bfhi(b.w);
                    *(u32x4*)(yp + bj * HALF) = pack8(v0, v1); } }
            asm volatile("" ::: "memory"); }
    }
};
template <bool F32IN>
struct EpiRes {
    static constexpr bool PERM = true, AFTER_DRAIN = false; static constexpr int MID_T = 0;
    const float* basef; const bf16_t* baseh; bf16_t* Hh;
    __device__ __forceinline__ void mid(f32x4 (&)[2][2][4][2], const Unit&, int, int, int, int) const {}
    __device__ __forceinline__ void operator()(const f32x4 (&acc)[2][2][4][2], const Unit& u, int wr, int wc, int fr, int fq) const {
        const int row0 = u.pm * BM + wr * 64 + fr, col0 = u.pn * BM + wc * 32 + 8 * fq;
#pragma unroll
        for (int ai = 0; ai < 2; ++ai) {
            if constexpr (F32IN) {
                f32x4 rb[4][2][2];
#pragma unroll
                for (int m = 0; m < 4; ++m) { const size_t off = (size_t)(row0 + ai * HALF + m * 16) * D + col0;
#pragma unroll
                    for (int bj = 0; bj < 2; ++bj) { rb[m][bj][0] = *(const f32x4*)(basef + off + bj * HALF); rb[m][bj][1] = *(const f32x4*)(basef + off + bj * HALF + 4); } }
#pragma unroll
                for (int m = 0; m < 4; ++m) { const size_t off = (size_t)(row0 + ai * HALF + m * 16) * D + col0;
#pragma unroll
                    for (int bj = 0; bj < 2; ++bj) *(u32x4*)(Hh + off + bj * HALF) = pack8(rb[m][bj][0] + acc[ai][bj][m][0], rb[m][bj][1] + acc[ai][bj][m][1]); }
            } else {
                u32x4 rb[4][2];
#pragma unroll
                for (int m = 0; m < 4; ++m) { const size_t off = (size_t)(row0 + ai * HALF + m * 16) * D + col0;
#pragma unroll
                    for (int bj = 0; bj < 2; ++bj) rb[m][bj] = *(const u32x4*)(baseh + off + bj * HALF); }
#pragma unroll
                for (int m = 0; m < 4; ++m) { const size_t off = (size_t)(row0 + ai * HALF + m * 16) * D + col0;
#pragma unroll
                    for (int bj = 0; bj < 2; ++bj) { const u32x4 w = rb[m][bj]; f32x4 a0 = acc[ai][bj][m][0], a1 = acc[ai][bj][m][1];
                        a0.x += __uint_as_float(w.x << 16); a0.y += __uint_as_float(w.x & 0xffff0000u); a0.z += __uint_as_float(w.y << 16); a0.w += __uint_as_float(w.y & 0xffff0000u);
                        a1.x += __uint_as_float(w.z << 16); a1.y += __uint_as_float(w.z & 0xffff0000u); a1.z += __uint_as_float(w.w << 16); a1.w += __uint_as_float(w.w & 0xffff0000u);
                        *(u32x4*)(Hh + off + bj * HALF) = pack8(a0, a1); } }
            }
            asm volatile("" ::: "memory"); }
    }
};
struct EpiSilu {
    static constexpr bool PERM = true, AFTER_DRAIN = false; static constexpr int MID_T = 0;
    bf16_t* HBp;
    __device__ __forceinline__ void mid(f32x4 (&)[2][2][4][2], const Unit&, int, int, int, int) const {}
    __device__ __forceinline__ void operator()(const f32x4 (&acc)[2][2][4][2], const Unit& u, int wr, int wc, int fr, int fq) const {
        const int row0 = u.pm * BM + wr * 64 + fr, col0 = u.pn * HALF + wc * 32 + 8 * fq;
#pragma unroll
        for (int ai = 0; ai < 2; ++ai)
#pragma unroll
            for (int m = 0; m < 4; ++m) { f32x4 v0, v1;
#pragma unroll
                for (int i = 0; i < 4; ++i) { const float g0 = acc[ai][0][m][0][i], g1 = acc[ai][0][m][1][i]; v0[i] = g0 * fsig(g0) * acc[ai][1][m][0][i]; v1[i] = g1 * fsig(g1) * acc[ai][1][m][1][i]; }
                *(u32x4*)(HBp + (size_t)(row0 + ai * HALF + m * 16) * DE + col0) = pack8(v0, v1); }
    }
};
struct EpiBf16 {
    static constexpr bool PERM = true, AFTER_DRAIN = false; static constexpr int MID_T = 0;
    bf16_t* O; int ldc;
    __device__ __forceinline__ void mid(f32x4 (&)[2][2][4][2], const Unit&, int, int, int, int) const {}
    __device__ __forceinline__ void operator()(const f32x4 (&acc)[2][2][4][2], const Unit& u, int wr, int wc, int fr, int fq) const {
        const int row0 = u.pm * BM + wr * 64 + fr, col0 = u.pn * BM + wc * 32 + 8 * fq;
#pragma unroll
        for (int ai = 0; ai < 2; ++ai)
#pragma unroll
            for (int m = 0; m < 4; ++m) { bf16_t* rowp = O + (size_t)(row0 + ai * HALF + m * 16) * ldc + col0;
#pragma unroll
                for (int bj = 0; bj < 2; ++bj) *(u32x4*)(rowp + bj * HALF) = pack8(acc[ai][bj][m][0], acc[ai][bj][m][1]); }
    }
};
struct GroupedOrder {
    const int* tile_e; int ntot, G, vcu;
    __device__ void init(const int* te, int ntiles, int G_, int vcu_) { tile_e = te; ntot = ntiles * 4; G = G_; vcu = vcu_; }
    __device__ bool next(int i, Unit& u) const {
        const int L = i * G + vcu; if (L >= ntot) return false;
        u.pm = L >> 2; u.pn = L & 3; u.pb = __builtin_amdgcn_readfirstlane(__hip_atomic_load(tile_e + (L >> 2), __ATOMIC_RELAXED, __HIP_MEMORY_SCOPE_AGENT)) * 4 + (L & 3); return true;
    }
    __device__ __forceinline__ void a_ready(const Unit&) const {}
    __device__ __forceinline__ void done(const Unit&) const {}
};

template <class Epi, class Sched, bool ALIGN_EPI = false, bool SP2 = false>
__device__ __forceinline__ void gemm_phase(PG8_LAS unsigned char* lds, const Gemm g, const Sched& S, const Epi& E, int wv) {
    const int tid = opaque_tid(wv), wid = __builtin_amdgcn_readfirstlane(tid >> 6), lane = tid & 63, wr = wid >> 2, wc = wid & 3, fr = lane & 15, fq = lane >> 4;
    const int K = g.K, nt = K / BK;
    unsigned voffA[2], voffB[2];
#pragma unroll
    for (int i = 0; i < 2; ++i) { int R, C; stage_rc(tid * 16 + i * 8192, R, C); const int Rb = Epi::PERM ? ((R & ~31) + perm32(R & 31)) : R;
        voffA[i] = (unsigned)(R * K + C) * 2u; voffB[i] = (unsigned)(Rb * K + C) * 2u; }
    const size_t kstep = (size_t)(BK * 2);
    const size_t hstep = (size_t)HALF * K * 2;
    const size_t tstep = 2 * hstep;
    const unsigned ldsw = (unsigned)wid * 1024u;
    const int aoff = lds_byte(wr * 64 + fr, fq * 8), boff = lds_byte(wc * 32 + fr, fq * 8);
#define PG8_SA(b, h) (((b) * 2 + (h)) * HTB)
#define PG8_SB(b, h) ((4 + (b) * 2 + (h)) * HTB)
#define PG8_STAGE(bufoff, gbase, voff) do { _Pragma("unroll") for (int _i = 0; _i < 2; ++_i) \
        __builtin_amdgcn_global_load_lds((const unsigned*)((const char*)(gbase) + (voff)[_i]), (PG8_LAS unsigned*)(lds + (bufoff) + ldsw + _i * 8192), 16, 0, 0); } while (0)
#define PG8_LDA(dst, b, h) do { _Pragma("unroll") for (int m = 0; m < 4; ++m) _Pragma("unroll") for (int k = 0; k < 2; ++k) dst[m][k] = *(const PG8_LAS bf16x8*)(lds + PG8_SA(b, h) + aoff + m * 2048 + k * 1024); } while (0)
#define PG8_LDB(dst, b, h) do { _Pragma("unroll") for (int n = 0; n < 2; ++n) _Pragma("unroll") for (int k = 0; k < 2; ++k) dst[n][k] = *(const PG8_LAS bf16x8*)(lds + PG8_SB(b, h) + boff + n * 2048 + k * 1024); } while (0)
#define PG8_MMA(ai, bj, At, Bt) do { __builtin_amdgcn_s_setprio(1); _Pragma("unroll") for (int m = 0; m < 4; ++m) _Pragma("unroll") for (int n = 0; n < 2; ++n) _Pragma("unroll") for (int k = 0; k < 2; ++k) \
        acc[ai][bj][m][n] = __builtin_amdgcn_mfma_f32_16x16x32_bf16(Bt[n][k], At[m][k], acc[ai][bj][m][n], 0, 0, 0); __builtin_amdgcn_s_setprio(0); } while (0)
#define PG8_WAIT_V(n) asm volatile("s_waitcnt vmcnt(" #n ")" ::: "memory")
#define PG8_WAIT_L(n) asm volatile("s_waitcnt lgkmcnt(" #n ")" ::: "memory")
#define PG8_BAR __builtin_amdgcn_s_barrier()
#define PG8_SCHED __builtin_amdgcn_sched_barrier(0)
    Unit cur, nxt; int ui = 0;
    if (!S.next(0, cur)) return;
    f32x4 acc[2][2][4][2];
#pragma unroll
    for (int a = 0; a < 2; ++a)
#pragma unroll
        for (int b = 0; b < 2; ++b)
#pragma unroll
            for (int m = 0; m < 4; ++m)
#pragma unroll
                for (int n = 0; n < 2; ++n) acc[a][b][m][n] = (f32x4){0.f, 0.f, 0.f, 0.f};
    bf16x8 At[4][2], B0[2][2], B1[2][2];
    const char* cA = (const char*)g.A + (size_t)cur.pm * tstep; const char* cB = (const char*)g.Bt + (size_t)cur.pb * tstep;
    S.a_ready(cur);
    if constexpr (SP2) {
        PG8_STAGE(PG8_SB(0, 0), cB, voffB); PG8_STAGE(PG8_SB(0, 1), cB + hstep, voffB); PG8_STAGE(PG8_SA(0, 0), cA, voffA); PG8_STAGE(PG8_SA(0, 1), cA + hstep, voffA);
        if (wr == 1) PG8_BAR;
        PG8_WAIT_V(2); PG8_BAR;
        PG8_STAGE(PG8_SB(1, 0), cB + kstep, voffB); PG8_STAGE(PG8_SA(1, 0), cA + kstep, voffA); PG8_STAGE(PG8_SB(1, 1), cB + hstep + kstep, voffB);
        PG8_WAIT_V(6); PG8_BAR;
    } else {
        PG8_STAGE(PG8_SB(0, 0), cB, voffB); PG8_STAGE(PG8_SA(0, 0), cA, voffA); PG8_STAGE(PG8_SB(0, 1), cB + hstep, voffB); PG8_STAGE(PG8_SA(0, 1), cA + hstep, voffA);
        if (wr == 1) PG8_BAR;
        PG8_WAIT_V(4); PG8_BAR;
        PG8_STAGE(PG8_SB(1, 0), cB + kstep, voffB); PG8_STAGE(PG8_SA(1, 0), cA + kstep, voffA); PG8_STAGE(PG8_SB(1, 1), cB + hstep + kstep, voffB);
        PG8_WAIT_V(6); PG8_BAR;
    }
    for (;;) {
        const bool has_next = S.next(ui + 1, nxt);
        const char* nA = has_next ? (const char*)g.A + (size_t)nxt.pm * tstep : cA; const char* nB = has_next ? (const char*)g.Bt + (size_t)nxt.pb * tstep : cB;
        for (int t = 0; t < nt; t += 2) {
            const bool last = (t == nt - 2);
            const char* a1 = cA + (size_t)(t + 1) * kstep;
            const char* a2 = last ? nA : cA + (size_t)(t + 2) * kstep; const char* b2 = last ? nB : cB + (size_t)(t + 2) * kstep;
            const char* a3 = a2 + kstep; const char* b3 = b2 + kstep;
            if (last && has_next) S.a_ready(nxt);
            if constexpr (Epi::MID_T > 0) { if (t == Epi::MID_T) E.mid(acc, cur, wr, wc, fr, fq); }
            if constexpr (SP2) {
            PG8_LDB(B0, 0, 0); PG8_LDB(B1, 0, 1); PG8_SCHED; PG8_LDA(At, 0, 0); PG8_STAGE(PG8_SA(1, 1), a1 + hstep, voffA);
            PG8_WAIT_V(8); PG8_WAIT_L(0); PG8_BAR; PG8_MMA(0, 0, At, B0); PG8_MMA(0, 1, At, B1); PG8_BAR; PG8_SCHED;
            PG8_LDA(At, 0, 1); PG8_STAGE(PG8_SB(0, 0), b2, voffB); PG8_STAGE(PG8_SB(0, 1), b2 + hstep, voffB); PG8_STAGE(PG8_SA(0, 0), a2, voffA);
            PG8_WAIT_V(8); PG8_WAIT_L(0); PG8_BAR; PG8_MMA(1, 0, At, B0); PG8_MMA(1, 1, At, B1); PG8_BAR; PG8_SCHED;
            PG8_LDB(B0, 1, 0); PG8_LDB(B1, 1, 1); PG8_SCHED; PG8_LDA(At, 1, 0); PG8_STAGE(PG8_SA(0, 1), a2 + hstep, voffA);
            PG8_WAIT_V(8); PG8_WAIT_L(0); PG8_BAR; PG8_MMA(0, 0, At, B0); PG8_MMA(0, 1, At, B1); PG8_BAR; PG8_SCHED;
            PG8_LDA(At, 1, 1); PG8_STAGE(PG8_SB(1, 0), b3, voffB); PG8_STAGE(PG8_SB(1, 1), b3 + hstep, voffB); PG8_STAGE(PG8_SA(1, 0), a3, voffA);
            PG8_WAIT_V(8); PG8_WAIT_L(0); PG8_BAR; PG8_MMA(1, 0, At, B0); PG8_MMA(1, 1, At, B1); PG8_BAR; PG8_SCHED;
            } else {
            PG8_LDB(B0, 0, 0); PG8_SCHED; PG8_LDA(At, 0, 0); PG8_STAGE(PG8_SA(1, 1), a1 + hstep, voffA);
            PG8_WAIT_L(8); PG8_BAR; PG8_WAIT_L(0); PG8_MMA(0, 0, At, B0); PG8_BAR; PG8_SCHED;
            PG8_LDB(B1, 0, 1); PG8_STAGE(PG8_SB(0, 0), b2, voffB);
            PG8_BAR; PG8_WAIT_L(0); PG8_MMA(0, 1, At, B1); PG8_BAR;
            PG8_LDA(At, 0, 1); PG8_STAGE(PG8_SA(0, 0), a2, voffA);
            PG8_BAR; PG8_WAIT_L(0); PG8_MMA(1, 0, At, B0); PG8_BAR; PG8_SCHED;
            PG8_STAGE(PG8_SB(0, 1), b2 + hstep, voffB);
            PG8_WAIT_V(6); PG8_BAR; PG8_MMA(1, 1, At, B1); PG8_BAR;
            PG8_LDB(B0, 1, 0); PG8_SCHED; PG8_LDA(At, 1, 0); PG8_STAGE(PG8_SA(0, 1), a2 + hstep, voffA);
            PG8_WAIT_L(8); PG8_BAR; PG8_WAIT_L(0); PG8_MMA(0, 0, At, B0); PG8_BAR; PG8_SCHED;
            PG8_LDB(B1, 1, 1); PG8_STAGE(PG8_SB(1, 0), b3, voffB);
            PG8_BAR; PG8_WAIT_L(0); PG8_MMA(0, 1, At, B1); PG8_BAR;
            PG8_LDA(At, 1, 1); PG8_STAGE(PG8_SA(1, 0), a3, voffA);
            PG8_BAR; PG8_WAIT_L(0); PG8_MMA(1, 0, At, B0); PG8_BAR; PG8_SCHED;
            PG8_STAGE(PG8_SB(1, 1), b3 + hstep, voffB);
            PG8_WAIT_V(6); PG8_BAR; PG8_MMA(1, 1, At, B1); PG8_BAR;
            }
        }
        if constexpr (ALIGN_EPI) { if (wr == 0) PG8_BAR; }
        if constexpr (!Epi::AFTER_DRAIN) { E(acc, cur, wr, wc, fr, fq); S.done(cur); }
        if (!has_next) break;
#pragma unroll
        for (int a = 0; a < 2; ++a)
#pragma unroll
            for (int b = 0; b < 2; ++b)
#pragma unroll
                for (int m = 0; m < 4; ++m)
#pragma unroll
                    for (int n = 0; n < 2; ++n) acc[a][b][m][n] = (f32x4){0.f, 0.f, 0.f, 0.f};
        cur = nxt; cA = nA; cB = nB; ++ui;
        if constexpr (ALIGN_EPI) { if (wr == 1) PG8_BAR; }
    }
    PG8_WAIT_V(0);
    if constexpr (!ALIGN_EPI) { if (wr == 0) PG8_BAR; }
    PG8_BAR;
    if constexpr (Epi::AFTER_DRAIN) { E.fused(acc, cur, wr, wc, fr, fq, lds, wid, lane); S.done(cur); }
#undef PG8_SA
#undef PG8_SB
#undef PG8_STAGE
#undef PG8_LDA
#undef PG8_LDB
#undef PG8_MMA
#undef PG8_WAIT_V
#undef PG8_WAIT_L
#undef PG8_BAR
#undef PG8_SCHED
}
}


namespace moe {
typedef short bf16x8 __attribute__((ext_vector_type(8)));
typedef short s16x4 __attribute__((ext_vector_type(4)));
constexpr int BK = 64, TILE_B = 256 * BK * 2, STAGE_B = 2 * TILE_B;
__device__ __forceinline__ int lds_byte2(int r, int c) { const int st = (r >> 4) * 2 + (c >> 5), ob = (r & 15) * 64 + (c & 31) * 2; return st * 1024 + (ob ^ (((ob >> 9) & 1) << 5)); }
__device__ __forceinline__ void stage_rc2(int b, int& R, int& C) { const int st = b >> 10, sb = b & 1023, swz = sb ^ (((sb >> 9) & 1) << 5); R = (st / 2) * 16 + swz / 64; C = (st % 2) * 32 + (swz % 64) / 2; }
__device__ __forceinline__ void glds16_asm(const void* sbase, unsigned voff, unsigned lds_dst) { unsigned keep;
    asm volatile("s_mov_b32 %0, m0\n\ts_mov_b32 m0, %3\n\ts_nop 0\n\tglobal_load_lds_dwordx4 %1, %2\n\ts_mov_b32 m0, %0" : "=&s"(keep) : "v"(voff), "s"(sbase), "s"(lds_dst) : "memory"); }
__device__ __forceinline__ s16x4 tr16(LAS const unsigned char* p) { return __builtin_bit_cast(s16x4, __builtin_amdgcn_ds_read_tr16_b64_v4i16((LAS s16x4*)p)); }

template <int MODE>
__device__ __forceinline__ void gemm_phase(LAS unsigned char* lds, const bf16_t* A, int K, const float* W0, const float* W1, bf16_t* O, const int* tile_e, const int* src_map, const float* rstd, const float* kgain, int* ready, int ntiles, int G_, int vcu, int wv) {
    const int tid = opaque_tid(wv), wid = __builtin_amdgcn_readfirstlane(tid >> 6), lane = tid & 63, wr = wid >> 2, wc = wid & 3, fr = lane & 15, fq = lane >> 4;
    const int nt = K / BK, ntot = ntiles * 4;
    const unsigned lds0 = (unsigned)(uintptr_t)lds;
    LAS unsigned* avl = (LAS unsigned*)(lds + 2 * STAGE_B + 1024) + 4 * tid;
    constexpr int NW = (MODE == 0) ? DE : D;
    unsigned avoff = 0u; if (MODE == 1) { int R, C; stage_rc2(wid * 1024 + lane * 16, R, C); avoff = (unsigned)(R * K + C) * 2u; }
    const int krow = (MODE == 0) ? 2 * (wid >> 1) + (lane >> 5) : wid;
    const int hcol = 4 * (lane & 31);
    const int bcol = (MODE == 0) ? 64 * (hcol >> 5) + 32 * (wid & 1) + (hcol & 31) : 4 * lane;
    const unsigned wsrcb = (unsigned)((MODE == 0) ? (lane >> 5) * NW + hcol : 4 * lane) * 4u;
    const int c32 = bcol & 31, pos = (bcol & ~31) + 16 * ((c32 >> 2) & 1) + 4 * (c32 >> 3);
    const int bw_even = krow * 512 + ((pos * 2) ^ ((krow & 3) << 5)), bw_odd = krow * 512 + ((pos * 2) ^ (((krow & 3) | 4) << 5));
    const int aread0 = lds_byte2(wr * 128 + fr, fq * 8);
    const int tq = fr >> 2, tp = fr & 3, fx = (tq | ((fq & 1) << 2)) << 5;
    int bread[4];
#pragma unroll
    for (int n = 0; n < 4; ++n) bread[n] = (8 * fq + tq) * 512 + (((wc * 64 + 16 * n + 4 * tp) * 2) ^ fx);
    auto wait_ready = [&](int rt_) {
        if (opaque_tid(wv) == 0) {
            unsigned sp = 0;
            while (__hip_atomic_load(ready + rt_, __ATOMIC_RELAXED, __HIP_MEMORY_SCOPE_AGENT) < 4) { __builtin_amdgcn_s_sleep(2); if (++sp > (1u << 22)) break; }
            __builtin_amdgcn_fence(__ATOMIC_ACQUIRE, "agent");
            asm volatile("s_waitcnt vmcnt(0)" ::: "memory");
        }
        __syncthreads();
    };
    auto set_avl = [&](int rt_, int par_) {
        const int t2 = opaque_tid(wv); int R, C; stage_rc2((t2 >> 6) * 1024 + (t2 & 63) * 16, R, C);
        LAS unsigned* av = (LAS unsigned*)(lds + 2 * STAGE_B + 1024 + par_ * 8192) + 4 * t2;
#pragma unroll
        for (int i = 0; i < 4; ++i) av[i] = (unsigned)src_map[rt_ * 256 + R + 64 * i] * (unsigned)(K * 2) + (unsigned)C * 2u;
    };
    auto mk_wrs = [&](int e_, int ct_) -> __amdgpu_buffer_rsrc_t {
        const float* Wbase = (MODE == 0 ? ((wid & 1) ? W1 : W0) + (size_t)e_ * K * NW + ct_ * 128 + (size_t)(2 * (wid >> 1)) * NW : W0 + (size_t)e_ * K * NW + ct_ * 256 + (size_t)wid * NW);
        const unsigned long long wb_u = (unsigned long long)(uintptr_t)Wbase;
        const unsigned wb_lo = __builtin_amdgcn_readfirstlane((unsigned)wb_u), wb_hi = __builtin_amdgcn_readfirstlane((unsigned)(wb_u >> 32));
        return __builtin_amdgcn_make_buffer_rsrc((void*)(uintptr_t)(((unsigned long long)wb_hi << 32) | wb_lo), (short)0, (int)(K * NW * 4), 0x00020000);
    };
    int rt, ct;
    const int dn_a = ntot / G_, dn_rem = ntot - dn_a * G_, dn_n0 = G_ - dn_rem;
    auto unit_at = [&](int k) -> int {
        if (MODE == 0) { const int L = k * G_ + vcu; return L < ntot ? L : -1; }
        if (k < dn_a) return k * G_ + (G_ - 1 - vcu);
        int e = -1;
        if (vcu >= dn_rem) { const int w = G_ - 1 - vcu; if (k == dn_a) e = w; else if (k == dn_a + 1) e = dn_n0 + w; }
        else if (k == dn_a) e = 2 * dn_n0 + vcu;
        return (e >= 0 && e < dn_rem) ? dn_a * G_ + e : -1;
    };
    { const int L = unit_at(0); if (L < 0) return; rt = L >> 2; ct = L & 3; }
    if (MODE == 1) wait_ready(rt);
    int par = 0;
    if (MODE == 0) set_avl(rt, 0);
    __amdgpu_buffer_rsrc_t wrs = mk_wrs(__builtin_amdgcn_readfirstlane(__hip_atomic_load(tile_e + rt, __ATOMIC_RELAXED, __HIP_MEMORY_SCOPE_AGENT)), ct);
    const bf16_t* Ab = A + (size_t)rt * 256 * K;
    f32x4 acc[8][4];
    f32x4 rb[8]; float gv = 1.f;
#define MOE_SA(b) (lds + (b) * STAGE_B)
#define MOE_SB(b) (lds + (b) * STAGE_B + TILE_B)
#define MOE_GLDS_A(buf, kt, Abx, parx) do { u32x4 vo_ = {avoff, avoff, avoff, avoff}; if (MODE == 0) vo_ = *(LAS const u32x4*)((LAS unsigned*)(lds + 2 * STAGE_B + 1024 + (parx) * 8192) + 4 * opaque_tid(wv));     \
        _Pragma("unroll") for (int i = 0; i < 4; ++i) \
        glds16_asm((MODE == 0 ? A : (Abx) + (size_t)i * 64 * K) + (kt) * BK, vo_[i], (unsigned)__builtin_amdgcn_readfirstlane(lds0 + (buf) * STAGE_B + wid * 1024 + i * 8192)); } while (0)
#define MOE_ISSUE_B(rs_, kt) do { if (MODE == 0) gv = kgain[(kt) * BK + (opaque_tid(wv) & 63)];     \
        _Pragma("unroll") for (int q = 0; q < 8; ++q) rb[q] = __builtin_bit_cast(f32x4, __builtin_amdgcn_raw_buffer_load_b128(rs_, (int)wsrcb, (int)(((kt) * BK + 8 * q) * NW * 4), 0)); } while (0)
#define MOE_WRITE_B(buf, kt) do { const int l_ = opaque_tid(wv) & 63;     \
        const int kr_ = (MODE == 0) ? 2 * (wid >> 1) + (l_ >> 5) : wid, hc_ = 4 * (l_ & 31), bc_ = (MODE == 0) ? 64 * (hc_ >> 5) + 32 * (wid & 1) + (hc_ & 31) : 4 * l_; \
        const int c3_ = bc_ & 31, ps_ = (bc_ & ~31) + 16 * ((c3_ >> 2) & 1) + 4 * (c3_ >> 3); \
        const int be_ = kr_ * 512 + ((ps_ * 2) ^ ((kr_ & 3) << 5)), bo_ = be_ ^ 128; \
        float gq_[8]; if (MODE == 0) { _Pragma("unroll") for (int q = 0; q < 8; ++q) gq_[q] = __builtin_bit_cast(float, __builtin_amdgcn_ds_bpermute((8 * q + kr_) * 4, __builtin_bit_cast(int, gv))); }     \
        _Pragma("unroll") for (int q = 0; q < 8; ++q) { u32x2 w; \
            if (MODE == 0) { w.x = pk2(rb[q].x * gq_[q], rb[q].y * gq_[q]); w.y = pk2(rb[q].z * gq_[q], rb[q].w * gq_[q]); } else { w.x = pk2(rb[q].x, rb[q].y); w.y = pk2(rb[q].z, rb[q].w); } \
            *(LAS u32x2*)(MOE_SB(buf) + ((q & 1) ? bo_ : be_) + q * 4096) = w; } } while (0)
#define MOE_COMPUTE(cur) do { __builtin_amdgcn_sched_barrier(0); \
            _Pragma("unroll") for (int ks = 0; ks < 2; ++ks) { \
                bf16x8 Bf[4]; \
                _Pragma("unroll") for (int n = 0; n < 4; ++n) { const s16x4 b0 = tr16(MOE_SB(cur) + bread[n] + ks * 16384), b1 = tr16(MOE_SB(cur) + bread[n] + ks * 16384 + 2048); Bf[n] = __builtin_shufflevector(b0, b1, 0, 1, 2, 3, 4, 5, 6, 7); } \
                _Pragma("unroll") for (int mh = 0; mh < 2; ++mh) { bf16x8 At[4]; \
                    _Pragma("unroll") for (int m = 0; m < 4; ++m) At[m] = *(LAS const bf16x8*)(MOE_SA(cur) + aread0 + (4 * mh + m) * 2048 + ks * 1024); \
                    _Pragma("unroll") for (int m = 0; m < 4; ++m) _Pragma("unroll") for (int n = 0; n < 4; ++n) acc[4 * mh + m][n] = __builtin_amdgcn_mfma_f32_16x16x32_bf16(Bf[n], At[m], acc[4 * mh + m][n], 0, 0, 0); \
                    __builtin_amdgcn_sched_barrier(0); } } } while (0)
#define MOE_END8() do { asm volatile("s_waitcnt vmcnt(8) lgkmcnt(0)" ::: "memory"); __builtin_amdgcn_s_barrier(); } while (0)
#define MOE_END0() do { asm volatile("s_waitcnt vmcnt(0) lgkmcnt(0)" ::: "memory"); __builtin_amdgcn_s_barrier(); } while (0)
#define MOE_STEP(cur, t) do { int tt_ = (t); asm volatile("" : "+s"(tt_));     \
        const bool own1 = tt_ + 1 < nt, own2 = tt_ + 2 < nt; \
        if (own1 || hn) { MOE_WRITE_B(1 - (cur), (own1 ? tt_ + 1 : 0)); __builtin_amdgcn_sched_barrier(0); MOE_GLDS_A(1 - (cur), (own1 ? (t) + 1 : 0), (own1 ? Ab : nAb), (own1 ? par : (par ^ 1))); } \
        if (MODE == 1 && (cur) == 0 && hn && tt_ == nt - 2) wait_ready(nrt); \
        if (own2 || hn) MOE_ISSUE_B((own2 ? wrs : nwrs), (own2 ? (t) + 2 : (t) + 2 - nt)); \
        MOE_COMPUTE(cur); \
        if (own2 || hn) MOE_END8(); else MOE_END0(); } while (0)
    MOE_ISSUE_B(wrs, 0); MOE_WRITE_B(0, 0); MOE_GLDS_A(0, 0, Ab, 0); MOE_ISSUE_B(wrs, 1);
    MOE_END0();
    int pend = -1;
    for (int ui = 0;; ++ui) {
        const int Ln = unit_at(ui + 1);
        const bool hn = Ln >= 0;
        const int nrt = Ln >> 2, nct = Ln & 3;
        __amdgpu_buffer_rsrc_t nwrs = wrs; const bf16_t* nAb = Ab;
        if (hn) {
            nwrs = mk_wrs(__builtin_amdgcn_readfirstlane(__hip_atomic_load(tile_e + nrt, __ATOMIC_RELAXED, __HIP_MEMORY_SCOPE_AGENT)), nct);
            nAb = A + (size_t)nrt * 256 * K;
            if (MODE == 0) set_avl(nrt, par ^ 1);
        }
        float zf = 0.f; asm volatile("" : "+v"(zf));
#pragma unroll
        for (int m = 0; m < 8; ++m)
#pragma unroll
            for (int n = 0; n < 4; ++n) acc[m][n] = (f32x4){zf, zf, zf, zf};
        for (int t = 0; t < nt; t += 2) {
            MOE_STEP(0, t);
            int t0_ = t; asm volatile("" : "+s"(t0_));
            if (MODE == 0 && t0_ == 0 && pend >= 0) { if (opaque_tid(wv) == 0) __hip_atomic_fetch_add(ready + pend, 1, __ATOMIC_RELAXED, __HIP_MEMORY_SCOPE_AGENT); }
            MOE_STEP(1, t + 1);
        }
        const int tid_e = opaque_tid(wv), fr_e = tid_e & 15, fq_e = (tid_e >> 4) & 3;
        const int row0 = rt * 256 + wr * 128 + fr_e;
        if (MODE == 0) {
            const unsigned long long ob_u = (unsigned long long)(uintptr_t)O;
            const unsigned ob_lo = (unsigned)__builtin_amdgcn_readfirstlane((unsigned)ob_u), ob_hi = (unsigned)__builtin_amdgcn_readfirstlane((unsigned)(ob_u >> 32));
            const __amdgpu_buffer_rsrc_t ors = __builtin_amdgcn_make_buffer_rsrc((void*)(uintptr_t)(((unsigned long long)ob_hi << 32) | ob_lo), (short)0, (int)((size_t)PMAX * DE * 2), 0x00020000);
            const int col0 = ct * 128 + wc * 32 + 8 * fq_e;
            float rs[8];
#pragma unroll
            for (int m = 0; m < 8; ++m) rs[m] = rstd[row0 + m * 16];
#pragma unroll
            for (int m = 0; m < 8; ++m) { f32x4 v0, v1;
#pragma unroll
                for (int i = 0; i < 4; ++i) { const float g0 = acc[m][0][i] * rs[m], g1 = acc[m][1][i] * rs[m]; v0[i] = g0 * pg8::fsig(g0) * (acc[m][2][i] * rs[m]); v1[i] = g1 * pg8::fsig(g1) * (acc[m][3][i] * rs[m]); }
                __builtin_amdgcn_raw_buffer_store_b128(pg8::pack8(v0, v1), ors, (int)(((unsigned)(row0 + m * 16) * DE + col0) * 2u), 0, 16);
                __builtin_amdgcn_sched_barrier(0); }
            pend = rt;
        } else {
            const int col0 = ct * 256 + wc * 64 + 8 * fq_e;
#pragma unroll
            for (int m = 0; m < 8; ++m) { bf16_t* rp = O + (size_t)(row0 + m * 16) * D + col0;
                *(u32x4*)rp = pg8::pack8(acc[m][0], acc[m][1]); *(u32x4*)(rp + 32) = pg8::pack8(acc[m][2], acc[m][3]); __builtin_amdgcn_sched_barrier(0); }
        }
        if (!hn) break;
        rt = nrt; ct = nct; wrs = nwrs; Ab = nAb; par ^= 1;
    }
    if (MODE == 0) {
        asm volatile("s_waitcnt vmcnt(0)" ::: "memory"); __syncthreads();
        if (opaque_tid(wv) == 0) __hip_atomic_fetch_add(ready + pend, 1, __ATOMIC_RELAXED, __HIP_MEMORY_SCOPE_AGENT);
    }
#undef MOE_STEP
#undef MOE_END8
#undef MOE_END0
#undef MOE_COMPUTE
#undef MOE_SA
#undef MOE_SB
#undef MOE_GLDS_A
#undef MOE_ISSUE_B
#undef MOE_WRITE_B
}
}

__device__ __forceinline__ void transpose_item(const float* W, int ldw, int k0, int n0, bf16_t* WT, size_t drow0, int dk0, int ldk, LAS float* scr, int lane, const float* ksc = nullptr) {
    f32x4 v[16];
#pragma unroll
    for (int i = 0; i < 16; ++i) v[i] = *(const f32x4*)(W + (size_t)(k0 + 4 * i + (lane >> 4)) * ldw + n0 + 4 * (lane & 15));
    if (ksc) {
#pragma unroll
        for (int i = 0; i < 16; ++i) { const float s = ksc[k0 + 4 * i + (lane >> 4)]; v[i].x *= s; v[i].y *= s; v[i].z *= s; v[i].w *= s; } }
#pragma unroll
    for (int i = 0; i < 16; ++i) { const int kk = 4 * i + (lane >> 4), nb4 = 4 * (lane & 15);
#pragma unroll
        for (int e = 0; e < 4; ++e) scr[kk * 64 + ((nb4 + e + kk) & 63)] = v[i][e]; }
    asm volatile("s_waitcnt lgkmcnt(0)" ::: "memory");
    const int cch = lane & 7;
#pragma unroll
    for (int j = 0; j < 8; ++j) { const int n = (lane >> 3) + 8 * j; float f[8];
#pragma unroll
        for (int q = 0; q < 8; ++q) { const int kk = 8 * cch + q; f[q] = scr[kk * 64 + ((n + kk) & 63)]; }
        u32x4 o; o.x = pk2(f[0], f[1]); o.y = pk2(f[2], f[3]); o.z = pk2(f[4], f[5]); o.w = pk2(f[6], f[7]);
        *(u32x4*)(WT + (drow0 + n) * (size_t)ldk + dk0 + 8 * cch) = o; }
    asm volatile("s_waitcnt lgkmcnt(0)" ::: "memory");
}
__device__ __forceinline__ void ph_prologue(const Ctx& c, int vcu, int nb, LAS unsigned char* lds, int wv) {
    const int tid = opaque_tid(wv);
    const int lane = tid & 63, wave = __builtin_amdgcn_readfirstlane(tid >> 6);
    LAS float* scr = (LAS float*)(lds + wave * 16384);
    const int gw = vcu * NWAVES + wave, ngw = nb * NWAVES;
    constexpr int I_IN = (D / 64) * (NIN / 64), I_PA = (AOW / 64) * (D / 64), I_OUT = (D / 64) * (D / 64);
    constexpr int I_DENSE = DEPTH * (I_IN + I_PA + I_OUT);
    for (int it = gw; it < I_DENSE; it += ngw) {
        int r = it;
        if (r < I_DENSE) {
            const int l = r / (I_IN + I_PA + I_OUT); r -= l * (I_IN + I_PA + I_OUT);
            if (r < I_IN) { const int kb = r / (NIN / 64), nbk = r % (NIN / 64); transpose_item(c.w_in + (size_t)l * D * NIN, NIN, 64 * kb, 64 * nbk, c.WIN() + (size_t)l * NIN * D, 64 * nbk, 64 * kb, D, scr, lane, c.norm_mix_g + (size_t)l * D); continue; }
            r -= I_IN;
            if (r < I_PA) { const int kb = r / (D / 64), nbk = r % (D / 64); transpose_item(c.w_proj_attn + (size_t)l * AOW * D, D, 64 * kb, 64 * nbk, c.WP() + (size_t)l * D * A2W, 64 * nbk, 64 * kb, A2W, scr, lane); continue; }
            r -= I_PA;
            { const int kb = r / (D / 64), nbk = r % (D / 64); transpose_item(c.w_out + (size_t)l * D * D, D, 64 * kb, 64 * nbk, c.WOUT() + (size_t)l * D * D, 64 * nbk, 64 * kb, D, scr, lane); continue; }
        }
    }
    for (int it = gw; it < DEPTH * 160; it += ngw) {
        const int l = it / 160, f = it % 160, ks = f / 5, nt = f % 5, g = lane >> 4, n = 16 * nt + (lane & 15);
        float wv[8];
#pragma unroll
        for (int j = 0; j < 8; ++j) { const int k = 32 * ks + 8 * g + j; float w = 0.f;
            if (n < NEG) w = c.w_rg[((size_t)l * D + k) * NEG + n];
            else if (n < NEG + NE) w = c.w_re[(((size_t)l * NEG + ((n - NEG) >> 3)) * D + k) * EPG + ((n - NEG) & 7)];
            wv[j] = w * c.norm_ffn_g[(size_t)l * D + k]; }
        u32x4 h, lo;
        const unsigned h0 = f2bf(wv[0]), h1 = f2bf(wv[1]), h2 = f2bf(wv[2]), h3 = f2bf(wv[3]), h4 = f2bf(wv[4]), h5 = f2bf(wv[5]), h6 = f2bf(wv[6]), h7 = f2bf(wv[7]);
        h.x = h0 | (h1 << 16); h.y = h2 | (h3 << 16); h.z = h4 | (h5 << 16); h.w = h6 | (h7 << 16);
        lo.x = pk2(wv[0] - __uint_as_float(h0 << 16), wv[1] - __uint_as_float(h1 << 16)); lo.y = pk2(wv[2] - __uint_as_float(h2 << 16), wv[3] - __uint_as_float(h3 << 16));
        lo.z = pk2(wv[4] - __uint_as_float(h4 << 16), wv[5] - __uint_as_float(h5 << 16)); lo.w = pk2(wv[6] - __uint_as_float(h6 << 16), wv[7] - __uint_as_float(h7 << 16));
        u32x4* dst = (u32x4*)c.WR() + (size_t)l * 2 * WR_FRAGS;
        dst[f * 64 + lane] = h; dst[WR_FRAGS + f * 64 + lane] = lo;
    }
    ph_x_to_h(c.x, c.H(), c.RSTDM(), vcu, nb, wv);
    ph_fold_wpc(c, vcu, nb, wv);
}

#define XB_TMO      128
#define XB_XCNT(j)  (256  + 64 * (j))
#define XB_XSUB(j)  (1280 + 64 * (j))
#define XB_XGEN(j)  (2304 + 64 * (j))
#define XB_TOP      3328
#define XB_TOPGEN   3392
#define XCD_BAR_WORDS 3456
#define XB_SPIN_CAP (1u << 18)

__device__ __forceinline__ unsigned xb_ld(unsigned* p)              { return __hip_atomic_load(p, __ATOMIC_RELAXED, __HIP_MEMORY_SCOPE_AGENT); }
__device__ __forceinline__ unsigned xb_add(unsigned* p, unsigned v) { return __hip_atomic_fetch_add(p, v, __ATOMIC_RELAXED, __HIP_MEMORY_SCOPE_AGENT); }
__device__ __forceinline__ unsigned xb_xcc_id() { return (unsigned)__builtin_amdgcn_s_getreg((3 << 11) | 20) & 0xFu; }
#define XB_SPIN(cond, bar) do { unsigned _sp = 0; while (cond) { __builtin_amdgcn_s_sleep(1); \
    if ((++_sp & 255u) == 0u) { if (xb_ld(&(bar)[XB_TMO])) break; if (_sp > XB_SPIN_CAP) { atomicAdd(&(bar)[XB_TMO], 1u); break; } } } } while (0)

struct XcdBarrier {
    unsigned* bar; unsigned x;
    volatile LAS unsigned* st;
};

__device__ __forceinline__ XcdBarrier xcd_barrier_post(unsigned* bar, volatile LAS unsigned* st, bool t0) {
    XcdBarrier b; b.bar = bar; b.x = xb_xcc_id(); b.st = st;
    if (t0) st[2] = xb_add(&bar[XB_XCNT(b.x)], 1u);
    return b;
}
__device__ __forceinline__ void xcd_barrier_complete(unsigned* bar, unsigned x, unsigned& nloc, unsigned& nx) {
    const unsigned G = gridDim.x * gridDim.y * gridDim.z;
    unsigned sum, cnt, mine, sp = 0u;
    for (;;) {
        sum = 0u; cnt = 0u; mine = 0u;
#pragma unroll
        for (unsigned j = 0; j < 16; ++j) { const unsigned c = xb_ld(&bar[XB_XCNT(j)]); sum += c; cnt += (c > 0u) ? 1u : 0u; mine = (j == x) ? c : mine; }
        if (sum == G) break;
        __builtin_amdgcn_s_sleep(1);
        if ((++sp & 255u) == 0u) { if (xb_ld(&bar[XB_TMO])) break; if (sp > XB_SPIN_CAP) { atomicAdd(&bar[XB_TMO], 1u); break; } }
    }
    nloc = mine > 0u ? mine : 1u; nx = cnt > 0u ? cnt : 1u;
}

__device__ __forceinline__ void xcd_barrier(const XcdBarrier& b, bool t0, bool light = false) {
    asm volatile("s_waitcnt vmcnt(0)" ::: "memory");
    __syncthreads();
    if (t0) {
        unsigned* bar = b.bar;
        __builtin_amdgcn_s_waitcnt(0);
        unsigned nloc = b.st[0], nx = b.st[1];
        if (nloc == 0u) { xcd_barrier_complete(bar, b.x, nloc, nx); b.st[0] = nloc; b.st[1] = nx; }
        const unsigned old = xb_add(&bar[XB_XSUB(b.x)], 1u);
        const unsigned gen = old / nloc;
        if (old + 1u == (gen + 1u) * nloc) {
            if (!light) {
            __builtin_amdgcn_fence(__ATOMIC_RELEASE, "agent");
            asm volatile("s_waitcnt vmcnt(0)" ::: "memory");
            const unsigned og = xb_add(&bar[XB_TOP], 1u);
            const unsigned tg = og / nx;
            if (og + 1u == (tg + 1u) * nx) xb_add(&bar[XB_TOPGEN], 1u);
            else XB_SPIN(xb_ld(&bar[XB_TOPGEN]) == tg, bar);
            }
            __builtin_amdgcn_fence(__ATOMIC_ACQUIRE, "agent");
            xb_add(&bar[XB_XGEN(b.x)], 1u);
            asm volatile("s_waitcnt vmcnt(0)" ::: "memory");
        } else {
            XB_SPIN(xb_ld(&bar[XB_XGEN(b.x)]) == gen, bar);
            __builtin_amdgcn_fence(__ATOMIC_ACQUIRE, "agent");
            asm volatile("s_waitcnt vmcnt(0)" ::: "memory");
        }
    }
    __syncthreads();
}

#ifndef MK_PROBE_REP
#define MK_PROBE_REP 0u
#endif
#ifndef MK_PROBE_L
#define MK_PROBE_L -1
#endif
#ifndef MK_XCD_BARRIER
#define MK_XCD_BARRIER 1
#endif
#ifndef MK_PER_PHASE
#define MK_PER_PHASE 0
#endif
constexpr int RING_BYTES = 131072, LDS_BYTES = 150528;
constexpr int PPL = 8;
constexpr int NPHASE = 1 + PPL * DEPTH;
struct Args { Ctx c; int ph_lo, ph_hi; };
namespace cg = cooperative_groups;

typedef const __attribute__((address_space(4))) Args* KArgsP;
#define LOAD_CTX() Ctx c; c.x = kp->c.x; c.rel_bias = kp->c.rel_bias; c.norm_mix_g = kp->c.norm_mix_g; c.w_in = kp->c.w_in; c.pool_w = kp->c.pool_w; c.pool_scale = kp->c.pool_scale; \
    c.w_proj_attn = kp->c.w_proj_attn; c.w_proj_pool = kp->c.w_proj_pool; c.w_out = kp->c.w_out; c.norm_ffn_g = kp->c.norm_ffn_g; c.w_rg = kp->c.w_rg; c.w_re = kp->c.w_re; \
    c.w_gate = kp->c.w_gate; c.w_up = kp->c.w_up; c.w_down = kp->c.w_down; c.norm_final_g = kp->c.norm_final_g; c.out = kp->c.out; c.ws = kp->c.ws
template <int KIND> __device__ __forceinline__ void run_phase(KArgsP kp, int l, LAS unsigned char* lds, int wv) {
    asm volatile("" : "+s"(kp));
    const int G_ = gridDim.x;
    int bx = blockIdx.x;
    int vcu = (G_ % 8 == 0) ? (bx % 8) * (G_ / 8) + bx / 8 : bx;
#if MK_XCD_BARRIER && !MK_PER_PHASE
    if constexpr (KIND != -1) { LAS const unsigned* misc = (LAS const unsigned*)(lds + RING_BYTES);
        vcu = __builtin_amdgcn_readfirstlane((int)misc[12]); bx = __builtin_amdgcn_readfirstlane((int)misc[13]); }
#endif
    LOAD_CTX();
    if constexpr (KIND == -1) ph_prologue(c, vcu, G_, lds, wv);
    else if constexpr (KIND == 0) { pg8::Gemm g{c.H(), c.WIN() + (size_t)l * NIN * D, T, NIN, D}; pg8::StaticOrder S; S.init(T, NIN, G_, bx);
        pg8::EpiProj E{c.PROJ(), c.RSTDM()}; pg8::gemm_phase<pg8::EpiProj, pg8::StaticOrder, true, true>(lds, g, S, E, wv); }
    else if constexpr (KIND == 1) { ph_attention(c, vcu, G_, lds, wv); ph_pool(c, vcu, G_, lds, wv); }
    else if constexpr (KIND == 2) { }
    else if constexpr (KIND == 3) { pg8::Gemm g{c.A2(), c.WP() + (size_t)l * D * A2W, T, D, A2W}; pg8::StaticOrder S; S.init(T, D, G_, bx);
        {
            pg8::Unit u; if (S.next(0, u)) {
                ph_merge64(c, u.pm * 256 + u.pn * 64, wv);
                asm volatile("s_waitcnt vmcnt(0)" ::: "memory"); __syncthreads();
                if (opaque_tid(wv) == 0) { int* pc = c.PANEL() + (l * 64 + u.pm) * 16;
                    __hip_atomic_fetch_add(pc, 1, __ATOMIC_RELAXED, __HIP_MEMORY_SCOPE_AGENT);
                    unsigned sp = 0; while (__hip_atomic_load(pc, __ATOMIC_RELAXED, __HIP_MEMORY_SCOPE_AGENT) < 4) { __builtin_amdgcn_s_sleep(1); if (++sp > (1u << 22)) break; }
                    __builtin_amdgcn_fence(__ATOMIC_ACQUIRE, "agent"); asm volatile("s_waitcnt vmcnt(0)" ::: "memory"); }
                __syncthreads(); } }
        pg8::EpiGate E{c.PROJ(), c.Y()}; pg8::gemm_phase<pg8::EpiGate, pg8::StaticOrder, true, true>(lds, g, S, E, wv); }
    else if constexpr (KIND == 4) { pg8::Gemm g{c.Y(), c.WOUT() + (size_t)l * D * D, T, D, D}; pg8::StaticOrder S; S.init(T, D, G_, bx);
        pg8::EpiRes<false> E{c.x, c.H(), c.H()}; pg8::gemm_phase<pg8::EpiRes<false>, pg8::StaticOrder, true, true>(lds, g, S, E, wv); }
    else if constexpr (KIND == 5) ph_router(c, l, vcu, G_, lds, wv);
    else if constexpr (KIND == 6) ph_scatter(c, l, vcu, G_, (LAS int*)lds, wv);
    else if constexpr (KIND == 7) { const int ntiles = __builtin_amdgcn_readfirstlane(__hip_atomic_load(c.META(), __ATOMIC_RELAXED, __HIP_MEMORY_SCOPE_AGENT));
        moe::gemm_phase<0>(lds, c.H(), D, c.w_gate + (size_t)l * NE * D * DE, c.w_up + (size_t)l * NE * D * DE, c.HB(), c.TILEE(), c.SRC(), c.RS(), c.norm_ffn_g + (size_t)l * D, c.READY() + l * 256, ntiles, G_, vcu, wv);
        moe::gemm_phase<1>(lds, c.HB(), DE, c.w_down + (size_t)l * NE * DE * D, c.w_down + (size_t)l * NE * DE * D, c.YPAD(), c.TILEE(), c.SRC(), c.RS(), c.norm_ffn_g, c.READY() + l * 256, ntiles, G_, vcu, wv); }
    else if constexpr (KIND == 8) { }
    else ph_combine(c, l, vcu, G_, wv);
}
__device__ __forceinline__ void seam(KArgsP kp, LAS unsigned char* lds, int wv, bool light = false) {
    const bool t0 = (opaque_tid(wv) == 0);
#if MK_XCD_BARRIER
    XcdBarrier b; b.bar = (unsigned*)(kp->c.ws + WS_CTL + CT_BAR); b.x = xb_xcc_id(); b.st = (volatile LAS unsigned*)(lds + RING_BYTES) + 8;
#if !MK_PER_PHASE
    light = light && (b.st[3] != 0u);
#else
    light = false;
#endif
    xcd_barrier(b, t0, light);
#else
    cg::this_grid().sync();
#endif
}
__device__ __forceinline__ void setup_map(KArgsP kp, LAS unsigned char* lds, int wv) {
#if MK_XCD_BARRIER && !MK_PER_PHASE
    volatile LAS unsigned* misc = (volatile LAS unsigned*)(lds + RING_BYTES);
    if (opaque_tid(wv) == 0) {
        unsigned* bar = (unsigned*)(kp->c.ws + WS_CTL + CT_BAR);
        bool uni = (gridDim.x == 256u) && (gridDim.y * gridDim.z == 1u);
#pragma unroll
        for (unsigned j = 0; j < 16; ++j) { const unsigned cj = xb_ld(&bar[XB_XCNT(j)]); uni = uni && (cj == (j < 8u ? 32u : 0u)); }
        const unsigned x = xb_xcc_id(), r = misc[10];
        uni = uni && (x < 8u) && (r < 32u);
        const unsigned bxr = blockIdx.x;
        misc[11] = uni ? 1u : 0u;
        misc[12] = uni ? (x * 32u + r) : ((bxr % 8u) * (gridDim.x / 8u) + bxr / 8u);
        misc[13] = uni ? (r * 8u + x) : bxr;
    }
    __syncthreads();
#endif
}
__global__ void __launch_bounds__(NTHR, 2) mega(Args a) {
    extern __shared__ __attribute__((aligned(16))) unsigned char lds_raw[];
    LAS unsigned char* lds = (LAS unsigned char*)lds_raw;
    KArgsP kp = (KArgsP)__builtin_amdgcn_kernarg_segment_ptr();
#if !MK_PER_PHASE && MK_XCD_BARRIER
    const int wv = __builtin_amdgcn_readfirstlane((int)threadIdx.x >> 6);
    { volatile LAS unsigned* misc = (volatile LAS unsigned*)(lds + RING_BYTES); const int t = opaque_tid(wv);
      if (t < 16) misc[t] = 0u;
      __syncthreads();
      (void)xcd_barrier_post((unsigned*)(kp->c.ws + WS_CTL + CT_BAR), misc + 8, t == 0); }
#endif
    const int ph_lo = kp->ph_lo, ph_hi = kp->ph_hi;
#define LIGHT_SEAM(ph_) ((((ph_) - 1) % PPL >= 1 && ((ph_) - 1) % PPL <= 4) || (((ph_) - 1) % PPL == 0 && (ph_) > 1))
#define RUN(ph, KIND, L) do { const int ph_ = (ph); if (ph_lo <= ph_ && ph_ < ph_hi) { if (ph_ > ph_lo) seam(kp, lds, wv, LIGHT_SEAM(ph_)); if (ph_ == 1 && ph_lo == 0) setup_map(kp, lds, wv); run_phase<KIND>(kp, (L), lds, wv); \
        if (((MK_PROBE_REP >> ((KIND) + 1)) & 1) && (MK_PROBE_L < 0 || (L) == MK_PROBE_L)) { seam(kp, lds, wv); run_phase<KIND>(kp, (L), lds, wv); } } } while (0)
    RUN(0, -1, 0);
#define LAYER(l) do { constexpr int b0 = 1 + PPL * (l); \
        RUN(b0 + 0, 0, l); RUN(b0 + 1, 1, l); RUN(b0 + 2, 3, l); RUN(b0 + 3, 4, l); \
        RUN(b0 + 4, 5, l); RUN(b0 + 5, 6, l); RUN(b0 + 6, 7, l); RUN(b0 + 7, 9, l); } while (0)
    static_assert(DEPTH == 2, "two layers written out");
    LAYER(0); LAYER(1);
#undef LAYER
#undef RUN
}

extern "C" void kernel_launch(void* const* d_in, const int* in_sizes, int n_in, void* d_out, int out_size, void* d_ws, size_t ws_size, hipStream_t stream) {
    static int ready = 0;
    if (ready == 0) {
        if (n_in != 16 || in_sizes[0] != T * D || out_size != T * D || ws_size < WS_END) {
            fprintf(stderr, "kernel_launch: unexpected shapes: n_in %d in0 %d out %d ws %zu (need %zu)\n", n_in, n_in > 0 ? in_sizes[0] : -1, out_size, ws_size, (size_t)WS_END); ready = -1; return; }
        if (hipFuncSetAttribute((const void*)mega, hipFuncAttributeMaxDynamicSharedMemorySize, LDS_BYTES) != hipSuccess) { fprintf(stderr, "kernel_launch: hipFuncSetAttribute failed\n"); ready = -1; return; }
        int per_cu = 0;
        if (hipOccupancyMaxActiveBlocksPerMultiprocessor(&per_cu, (const void*)mega, NTHR, LDS_BYTES) != hipSuccess || per_cu < 1) fprintf(stderr, "kernel_launch: occupancy query says %d blocks/CU\n", per_cu);
        (void)hipGetLastError();
        ready = 1;
    }
    if (ready < 0) return;
    Args a{};
    Ctx& c = a.c;
    c.x = (const float*)d_in[0]; c.rel_bias = (const float*)d_in[1]; c.norm_mix_g = (const float*)d_in[2]; c.w_in = (const float*)d_in[3];
    c.pool_w = (const float*)d_in[4]; c.pool_scale = (const float*)d_in[5]; c.w_proj_attn = (const float*)d_in[6]; c.w_proj_pool = (const float*)d_in[7];
    c.w_out = (const float*)d_in[8]; c.norm_ffn_g = (const float*)d_in[9]; c.w_rg = (const float*)d_in[10]; c.w_re = (const float*)d_in[11];
    c.w_gate = (const float*)d_in[12]; c.w_up = (const float*)d_in[13]; c.w_down = (const float*)d_in[14]; c.norm_final_g = (const float*)d_in[15];
    c.out = (float*)d_out; c.ws = (unsigned char*)d_ws;
#if MK_PER_PHASE
    for (int ph = 0; ph < NPHASE; ++ph) { a.ph_lo = ph; a.ph_hi = ph + 1; hipLaunchKernelGGL(mega, dim3(G), dim3(NTHR), LDS_BYTES, stream, a); }
#else
    a.ph_lo = 0; a.ph_hi = NPHASE;
    if (hipMemsetAsync((char*)d_ws + WS_CTL + CT_BAR, 0, CT_BAR_BYTES, stream) != hipSuccess) { fprintf(stderr, "kernel_launch: hipMemsetAsync failed\n"); return; }
    void* args[] = {&a};
    hipError_t e = hipLaunchCooperativeKernel((const void*)mega, dim3(G), dim3(NTHR), args, LDS_BYTES, stream);
    if (e != hipSuccess) fprintf(stderr, "cooperative launch failed: %s\n", hipGetErrorString(e));
#endif
}
```

```cpp
#include <hip/hip_runtime.h>
#include <hip/hip_cooperative_groups.h>
#include <cstdio>
#include <cstdint>

constexpr int NB_ = 8, SEQ = 2048, T = NB_ * SEQ, D = 1024, DEPTH = 2;
constexpr int HD = 64, HPG = 4, NH = 12, AW = 768, AOW = 256;
constexpr int PW = 512, PGW = 128;
constexpr int NIN = 4864, COL_K = 768, COL_V = 1536, COL_U = 2304, COL_G = 2816;
constexpr int NEG = 8, EPG = 8, NE = 64, DE = 512;
constexpr int A2W = AOW + PW;
constexpr int PTILE = 256;
constexpr int PMAX_TILES = T * 2 / PTILE + NE;
constexpr int PMAX = PMAX_TILES * PTILE;
constexpr float EPS = 1e-6f;
constexpr int G = 256;
constexpr int NTHR = 512, NWAVES = 8;

typedef unsigned short bf16_t;
typedef float f32x4 __attribute__((ext_vector_type(4)));
typedef unsigned u32x4 __attribute__((ext_vector_type(4)));
typedef unsigned u32x2 __attribute__((ext_vector_type(2)));
#define LAS __attribute__((address_space(3)))
#define GAS __attribute__((address_space(1)))

constexpr size_t MiB = 1u << 20;
constexpr size_t WS_CTL = 0;
constexpr size_t WS_XN = 1 * MiB;
constexpr size_t WS_PROJ = WS_XN + (size_t)T * D * 2;
constexpr size_t WS_XPAD = WS_PROJ;
constexpr size_t WS_HB = WS_XPAD + (size_t)PMAX * D * 2;
constexpr size_t WS_A2 = WS_PROJ + (size_t)T * NIN * 2;
constexpr size_t WS_Y = WS_A2 + (size_t)T * A2W * 2;
constexpr size_t WS_H = WS_Y + (size_t)T * D * 2;
constexpr size_t WS_YPAD = WS_H + (size_t)T * D * 4;
constexpr size_t WS_Y1 = WS_YPAD;
constexpr size_t WS_OG = WS_XN;
constexpr size_t WS_LSE = WS_OG + (size_t)3 * T * AOW * 2;
constexpr size_t WS_WPC = WS_YPAD + (size_t)PMAX * D * 2;
constexpr size_t WS_END0 = WS_WPC + (size_t)DEPTH * D * PW * 2;
constexpr size_t WS_WIN = WS_END0;
constexpr size_t WS_WP = WS_WIN + (size_t)DEPTH * NIN * D * 2;
constexpr size_t WS_WOUT = WS_WP + (size_t)DEPTH * D * A2W * 2;
constexpr size_t WS_WR = WS_WOUT + (size_t)DEPTH * D * D * 2;
constexpr size_t WS_END = WS_WR + (size_t)DEPTH * 2 * 32 * 5 * 64 * 16;
static_assert(WS_HB + (size_t)PMAX * DE * 2 <= WS_A2, "XPAD+HB alias PROJ");
static_assert((size_t)T * D * 4 <= (size_t)PMAX * D * 2, "Y1 aliases YPAD");
constexpr size_t CT_EID = 0;
constexpr size_t CT_CW = 128 * 1024;
constexpr size_t CT_DEST = 256 * 1024;
constexpr size_t CT_HIST = 384 * 1024;
constexpr size_t CT_TILEE = 448 * 1024;
constexpr size_t CT_META = 450 * 1024;
constexpr size_t CT_BAR = 512 * 1024;
constexpr size_t CT_BAR_BYTES = 24 * 1024;
constexpr size_t CT_PANEL = CT_BAR + 16 * 1024;
constexpr size_t CT_READY = CT_BAR + 14 * 1024;
constexpr size_t CT_RSTD = 576 * 1024;
constexpr size_t CT_RS = 832 * 1024;
constexpr size_t CT_SRC = 640 * 1024;

struct Ctx {
    const float *x, *rel_bias, *norm_mix_g, *w_in, *pool_w, *pool_scale, *w_proj_attn, *w_proj_pool, *w_out, *norm_ffn_g, *w_rg, *w_re, *w_gate, *w_up, *w_down, *norm_final_g;
    float* out;
    unsigned char* ws;
    __device__ __host__ bf16_t* XN() const { return (bf16_t*)(ws + WS_XN); }
    __device__ __host__ bf16_t* PROJ() const { return (bf16_t*)(ws + WS_PROJ); }
    __device__ __host__ bf16_t* HB() const { return (bf16_t*)(ws + WS_HB); }
    __device__ __host__ bf16_t* A2() const { return (bf16_t*)(ws + WS_A2); }
    __device__ __host__ bf16_t* Y() const { return (bf16_t*)(ws + WS_Y); }
    __device__ __host__ bf16_t* H() const { return (bf16_t*)(ws + WS_H); }
    __device__ __host__ float* RSTDM() const { return (float*)(ws + WS_H + (size_t)T * D * 2); }
    __device__ __host__ bf16_t* YPAD() const { return (bf16_t*)(ws + WS_YPAD); }
    __device__ __host__ bf16_t* OG() const { return (bf16_t*)(ws + WS_OG); }
    __device__ __host__ float* LSE() const { return (float*)(ws + WS_LSE); }
    __device__ __host__ bf16_t* WIN() const { return (bf16_t*)(ws + WS_WIN); }
    __device__ __host__ bf16_t* WP() const { return (bf16_t*)(ws + WS_WP); }
    __device__ __host__ bf16_t* WOUT() const { return (bf16_t*)(ws + WS_WOUT); }
    __device__ __host__ bf16_t* WR() const { return (bf16_t*)(ws + WS_WR); }
    __device__ __host__ float* RSTD() const { return (float*)(ws + WS_CTL + CT_RSTD); }
    __device__ __host__ int* SRC() const { return (int*)(ws + WS_CTL + CT_SRC); }
    __device__ __host__ float* RS() const { return (float*)(ws + WS_CTL + CT_RS); }
    __device__ __host__ int* READY() const { return (int*)(ws + WS_CTL + CT_READY); }
    __device__ __host__ int* PANEL() const { return (int*)(ws + WS_CTL + CT_PANEL); }
    __device__ __host__ int* EID() const { return (int*)(ws + WS_CTL + CT_EID); }
    __device__ __host__ float* CW() const { return (float*)(ws + WS_CTL + CT_CW); }
    __device__ __host__ int* DEST() const { return (int*)(ws + WS_CTL + CT_DEST); }
    __device__ __host__ int* HIST() const { return (int*)(ws + WS_CTL + CT_HIST); }
    __device__ __host__ int* TILEE() const { return (int*)(ws + WS_CTL + CT_TILEE); }
    __device__ __host__ int* META() const { return (int*)(ws + WS_CTL + CT_META); }
};

__device__ __forceinline__ float bf2f(bf16_t v) { return __uint_as_float((unsigned)v << 16); }
__device__ __forceinline__ unsigned f2bf(float f) { unsigned u = __float_as_uint(f); return (u + 0x7fffu + ((u >> 16) & 1u)) >> 16; }
typedef float f32x2_t __attribute__((ext_vector_type(2))); typedef __bf16 bf16x2_t __attribute__((ext_vector_type(2)));
__device__ __forceinline__ unsigned pk2(float lo, float hi) { f32x2_t v = {lo, hi}; bf16x2_t b = __builtin_convertvector(v, bf16x2_t); return __builtin_bit_cast(unsigned, b); }
template <int MASK> __device__ __forceinline__ float swz_xor(float v) { return __int_as_float(__builtin_amdgcn_ds_swizzle(__float_as_int(v), (MASK << 10) | 0x1f)); }
__device__ __forceinline__ float sum_x32(float v) {
    const auto r = __builtin_amdgcn_permlane32_swap(__float_as_uint(v), __float_as_uint(v), false, false); return __uint_as_float(r[0]) + __uint_as_float(r[1]); }
__device__ __forceinline__ float max_x32(float v) {
    const auto r = __builtin_amdgcn_permlane32_swap(__float_as_uint(v), __float_as_uint(v), false, false); return fmaxf(__uint_as_float(r[0]), __uint_as_float(r[1])); }
__device__ __forceinline__ float wave_sum(float v) { v += swz_xor<1>(v); v += swz_xor<2>(v); v += swz_xor<4>(v); v += swz_xor<8>(v); v += swz_xor<16>(v); return sum_x32(v); }
__device__ __forceinline__ float wave_max(float v) { v = fmaxf(v, swz_xor<1>(v)); v = fmaxf(v, swz_xor<2>(v)); v = fmaxf(v, swz_xor<4>(v)); v = fmaxf(v, swz_xor<8>(v)); v = fmaxf(v, swz_xor<16>(v)); return max_x32(v); }
__device__ __forceinline__ int opaque_tid(int wv) { int t; asm volatile("v_mbcnt_lo_u32_b32 %0, -1, 0\n\tv_mbcnt_hi_u32_b32 %0, -1, %0" : "=v"(t)); return wv * 64 + t; }
__device__ __forceinline__ float sigmoidf_(float v) { return 1.0f / (1.0f + __expf(-v)); }

__device__ __forceinline__ int t5_bucket(int rel) {
    const int n = rel < 0 ? -rel : rel; const int ret = rel > 0 ? 16 : 0;
    if (n < 8) return ret + n;
    int l = 8; l += (n >= 15); l += (n >= 27); l += (n >= 50); l += (n >= 91); l += (n >= 166); l += (n >= 305); l += (n >= 559);
    return ret + l;
}

__device__ __forceinline__ void ph_norm_rows(const float* src, const float* gain, bf16_t* dst, int vcu, int nb, int wv) {
    const int tid = opaque_tid(wv);
    const int lane = tid & 63, wave = tid >> 6;
    const int gw = vcu * NWAVES + wave, ngw = nb * NWAVES;
    f32x4 gn[4];
#pragma unroll
    for (int j = 0; j < 4; ++j) gn[j] = ((const f32x4*)gain)[lane + 64 * j];
    for (int m0 = gw * 4; m0 < T; m0 += ngw * 4) {
        f32x4 v[4][4];
#pragma unroll
        for (int q = 0; q < 4; ++q)
#pragma unroll
            for (int j = 0; j < 4; ++j) v[q][j] = ((const f32x4*)(src + (size_t)(m0 + q) * D))[lane + 64 * j];
#pragma unroll
        for (int q = 0; q < 4; ++q) {
            float s = 0.f;
#pragma unroll
            for (int j = 0; j < 4; ++j) s += (v[q][j].x * v[q][j].x + v[q][j].y * v[q][j].y) + (v[q][j].z * v[q][j].z + v[q][j].w * v[q][j].w);
            const float r = rsqrtf(wave_sum(s) * (1.f / D) + EPS);
            u32x2* o8 = (u32x2*)(dst + (size_t)(m0 + q) * D) + lane;
#pragma unroll
            for (int j = 0; j < 4; ++j) { u32x2 w; w.x = pk2(v[q][j].x * r * gn[j].x, v[q][j].y * r * gn[j].y); w.y = pk2(v[q][j].z * r * gn[j].z, v[q][j].w * r * gn[j].w); o8[64 * j] = w; }
        }
    }
}


__device__ __forceinline__ void ph_x_to_h(const float* src, bf16_t* dst, float* rs, int vcu, int nb, int wv) {
    const int tid = opaque_tid(wv);
    const int lane = tid & 63, wave = tid >> 6;
    const int gw = vcu * NWAVES + wave, ngw = nb * NWAVES;
    for (int m0 = gw * 4; m0 < T; m0 += ngw * 4) {
        f32x4 v[4][4];
#pragma unroll
        for (int q = 0; q < 4; ++q)
#pragma unroll
            for (int j = 0; j < 4; ++j) v[q][j] = ((const f32x4*)(src + (size_t)(m0 + q) * D))[lane + 64 * j];
#pragma unroll
        for (int q = 0; q < 4; ++q) {
            float s = 0.f;
#pragma unroll
            for (int j = 0; j < 4; ++j) s += (v[q][j].x * v[q][j].x + v[q][j].y * v[q][j].y) + (v[q][j].z * v[q][j].z + v[q][j].w * v[q][j].w);
            const float r = rsqrtf(wave_sum(s) * (1.f / D) + EPS);
            if (lane == 0) rs[m0 + q] = r;
            u32x2* o8 = (u32x2*)(dst + (size_t)(m0 + q) * D) + lane;
#pragma unroll
            for (int j = 0; j < 4; ++j) { u32x2 w; w.x = pk2(v[q][j].x, v[q][j].y); w.y = pk2(v[q][j].z, v[q][j].w); o8[64 * j] = w; }
        }
    }
}

__device__ __forceinline__ void ph_fold_wpc(const Ctx& c, int vcu, int nb, int wv) {
    const int tid = opaque_tid(wv);
    const int lane = tid & 63, wave = __builtin_amdgcn_readfirstlane(tid >> 6);
    const int gw = vcu * NWAVES + wave, ngw = nb * NWAVES;
    for (int it = gw; it < DEPTH * 4 * 16 * 16; it += ngw) {
        const int cc = it & 15, nbk = (it >> 4) & 15, g = (it >> 8) & 3, l = it >> 10;
        const int n = nbk * 64 + lane, c0 = cc * 8;
        const float* pw = c.pool_w + ((size_t)(l * 4 + g) * PGW + c0) * PGW;
        const float* ps = c.pool_scale + (size_t)l * PW + g * PGW;
        const float* wp = c.w_proj_pool + ((size_t)l * PW + g * PGW) * D + n;
        float acc[8];
#pragma unroll
        for (int i = 0; i < 8; ++i) acc[i] = 0.f;
#pragma unroll 4
        for (int e0 = 0; e0 < PGW; e0 += 8) {
            float w[8];
            const f32x4 s0 = *(const f32x4*)(ps + e0), s1 = *(const f32x4*)(ps + e0 + 4);
#pragma unroll
            for (int q = 0; q < 8; ++q) w[q] = wp[(size_t)(e0 + q) * D] * (q < 4 ? s0[q] : s1[q - 4]);
#pragma unroll
            for (int i = 0; i < 8; ++i) { const f32x4 a = *(const f32x4*)(pw + i * PGW + e0), b = *(const f32x4*)(pw + i * PGW + e0 + 4);
                acc[i] += (a.x * w[0] + a.y * w[1]) + (a.z * w[2] + a.w * w[3]) + (b.x * w[4] + b.y * w[5]) + (b.z * w[6] + b.w * w[7]); }
        }
        u32x4 w0; w0.x = pk2(acc[0], acc[1]); w0.y = pk2(acc[2], acc[3]); w0.z = pk2(acc[4], acc[5]); w0.w = pk2(acc[6], acc[7]);
        *(u32x4*)(c.WP() + ((size_t)l * D + n) * A2W + AOW + g * PGW + c0) = w0;
    }
}

typedef short bf16x8_r __attribute__((ext_vector_type(8)));
__device__ __forceinline__ void split8(const f32x4& x0, const f32x4& x1, bf16x8_r& hi, bf16x8_r& lo) {
    u32x4 h, l;
    const unsigned h0 = f2bf(x0.x), h1 = f2bf(x0.y), h2 = f2bf(x0.z), h3 = f2bf(x0.w), h4 = f2bf(x1.x), h5 = f2bf(x1.y), h6 = f2bf(x1.z), h7 = f2bf(x1.w);
    h.x = h0 | (h1 << 16); h.y = h2 | (h3 << 16); h.z = h4 | (h5 << 16); h.w = h6 | (h7 << 16);
    l.x = pk2(x0.x - __uint_as_float(h0 << 16), x0.y - __uint_as_float(h1 << 16)); l.y = pk2(x0.z - __uint_as_float(h2 << 16), x0.w - __uint_as_float(h3 << 16));
    l.z = pk2(x1.x - __uint_as_float(h4 << 16), x1.y - __uint_as_float(h5 << 16)); l.w = pk2(x1.z - __uint_as_float(h6 << 16), x1.w - __uint_as_float(h7 << 16));
    hi = __builtin_bit_cast(bf16x8_r, h); lo = __builtin_bit_cast(bf16x8_r, l);
}
constexpr int WR_FRAGS = 32 * 5 * 64;
__device__ __forceinline__ void ph_router(const Ctx& c, int layer, int vcu, int nb, LAS unsigned char* lds, int wv) {
    const int tid = opaque_tid(wv);
    const int lane = tid & 63, wave = __builtin_amdgcn_readfirstlane(tid >> 6), g = lane >> 4, cq = lane & 15;
    LAS float* slab = (LAS float*)lds;
    LAS float* lss = slab + 4 * 64 * 80;
    LAS int* lhist = (LAS int*)(lss + 256);
    const int t0 = vcu * 64;
    const bf16x8_r* WRh = (const bf16x8_r*)c.WR() + (size_t)layer * 2 * WR_FRAGS; const bf16x8_r* WRl = WRh + WR_FRAGS;
    f32x4 acc[4][5]; float ss[4] = {0.f, 0.f, 0.f, 0.f};
#pragma unroll
    for (int mi = 0; mi < 4; ++mi)
#pragma unroll
        for (int nt = 0; nt < 5; ++nt) acc[mi][nt] = (f32x4){0.f, 0.f, 0.f, 0.f};
    if (tid < NE) lhist[tid] = 0;
#pragma unroll
    for (int ks = 0; ks < 4; ++ks) {
        const int kk = 4 * wave + ks;
        bf16x8_r bh[5], bl[5];
#pragma unroll
        for (int nt = 0; nt < 5; ++nt) { bh[nt] = WRh[(kk * 5 + nt) * 64 + lane]; bl[nt] = WRl[(kk * 5 + nt) * 64 + lane]; }
#pragma unroll
        for (int mi = 0; mi < 4; ++mi) {
            const u32x4 hx = *(const u32x4*)(c.H() + (size_t)(t0 + 16 * mi + cq) * D + 32 * kk + 8 * g);
            f32x4 x0, x1;
            x0.x = __uint_as_float(hx.x << 16); x0.y = __uint_as_float(hx.x & 0xffff0000u); x0.z = __uint_as_float(hx.y << 16); x0.w = __uint_as_float(hx.y & 0xffff0000u);
            x1.x = __uint_as_float(hx.z << 16); x1.y = __uint_as_float(hx.z & 0xffff0000u); x1.z = __uint_as_float(hx.w << 16); x1.w = __uint_as_float(hx.w & 0xffff0000u);
            ss[mi] += (x0.x * x0.x + x0.y * x0.y) + (x0.z * x0.z + x0.w * x0.w) + (x1.x * x1.x + x1.y * x1.y) + (x1.z * x1.z + x1.w * x1.w);
            const bf16x8_r ah = __builtin_bit_cast(bf16x8_r, hx);
#pragma unroll
            for (int nt = 0; nt < 5; ++nt) {
                acc[mi][nt] = __builtin_amdgcn_mfma_f32_16x16x32_bf16(ah, bh[nt], acc[mi][nt], 0, 0, 0);
                acc[mi][nt] = __builtin_amdgcn_mfma_f32_16x16x32_bf16(ah, bl[nt], acc[mi][nt], 0, 0, 0);
            }
        }
    }
    LAS float* myslab = slab + (wave & 3) * 64 * 80;
#pragma unroll
    for (int mi = 0; mi < 4; ++mi) { float sv = ss[mi]; sv += swz_xor<16>(sv); ss[mi] = sum_x32(sv); }
    if (wave < 4) {
#pragma unroll
        for (int mi = 0; mi < 4; ++mi) {
#pragma unroll
            for (int nt = 0; nt < 5; ++nt)
#pragma unroll
                for (int j = 0; j < 4; ++j) myslab[(16 * mi + 4 * g + j) * 80 + 16 * nt + cq] = acc[mi][nt][j];
            if (g == 0) lss[(wave & 3) * 64 + 16 * mi + cq] = ss[mi];
        }
    }
    __syncthreads();
    if (wave >= 4) {
#pragma unroll
        for (int mi = 0; mi < 4; ++mi) {
#pragma unroll
            for (int nt = 0; nt < 5; ++nt)
#pragma unroll
                for (int j = 0; j < 4; ++j) myslab[(16 * mi + 4 * g + j) * 80 + 16 * nt + cq] += acc[mi][nt][j];
            if (g == 0) lss[(wave & 3) * 64 + 16 * mi + cq] += ss[mi];
        }
    }
    __syncthreads();
    if (tid < 64) {
        const int t = t0 + tid;
        const float r = rsqrtf(((lss[tid] + lss[64 + tid]) + (lss[128 + tid] + lss[192 + tid])) * (1.f / D) + EPS);
        LAS const float* s0 = slab + tid * 80;
        float a[8];
#pragma unroll
        for (int q = 0; q < 8; ++q) a[q] = ((s0[q] + s0[5120 + q]) + (s0[10240 + q] + s0[15360 + q])) * r;
        int gi = 0; float lmax = a[0];
#pragma unroll
        for (int q = 1; q < 8; ++q) if (a[q] > lmax) { lmax = a[q]; gi = q; }
        float se = 0.f;
#pragma unroll
        for (int q = 0; q < 8; ++q) se += __expf(a[q] - lmax);
        const float gp = 1.0f / se;
        float bq[8];
#pragma unroll
        for (int q = 0; q < 8; ++q) { const int n = 8 + gi * 8 + q; bq[q] = ((s0[n] + s0[5120 + n]) + (s0[10240 + n] + s0[15360 + n])) * r; }
        int i0 = 0; float v0 = bq[0];
#pragma unroll
        for (int q = 1; q < 8; ++q) if (bq[q] > v0) { v0 = bq[q]; i0 = q; }
        int i1 = -1; float v1 = -3.0e38f;
#pragma unroll
        for (int q = 0; q < 8; ++q) if (q != i0 && bq[q] > v1) { v1 = bq[q]; i1 = q; }
        const float e1 = __expf(v1 - v0), p0 = 1.0f / (1.0f + e1), p1 = e1 * p0;
        const int ea = gi * EPG + i0, eb = gi * EPG + i1;
        c.EID()[2 * t] = ea; c.EID()[2 * t + 1] = eb;
        c.CW()[2 * t] = gp * p0; c.CW()[2 * t + 1] = gp * p1;
        c.RSTD()[t] = r;
        __hip_atomic_fetch_add(&lhist[ea], 1, __ATOMIC_RELAXED, __HIP_MEMORY_SCOPE_WORKGROUP); __hip_atomic_fetch_add(&lhist[eb], 1, __ATOMIC_RELAXED, __HIP_MEMORY_SCOPE_WORKGROUP);
    }
    __syncthreads();
    if (tid < NE) c.HIST()[vcu * NE + tid] = lhist[tid];
    for (int i = vcu * NTHR + tid; i < PMAX; i += nb * NTHR) c.SRC()[i] = 0;
}


__device__ __forceinline__ void ph_scatter(const Ctx& c, int layer, int vcu, int nb, LAS int* lds, int wv) {
    const int tid = opaque_tid(wv);
    const int lane = tid & 63, wave = tid >> 6;
    const int TPB = T / nb, NA = 2 * TPB;
    LAS int* l_cnt = lds; LAS int* l_base = lds + 64; LAS int* l_poff = lds + 128; LAS int* l_eid = lds + 192; LAS int* l_dest = lds + 192 + NA; LAS int* l_pt = lds + 192 + 2 * NA; LAS int* l_pb = l_pt + 512;
    {
        const int e = tid & 63, part = tid >> 6, bper = nb / 8;
        int tot = 0, base = 0;
#pragma unroll 8
        for (int i = 0; i < bper; ++i) { const int b = part * bper + i; const int hv = c.HIST()[b * NE + e]; tot += hv; base += (b < vcu) ? hv : 0; }
        l_pt[part * 64 + e] = tot; l_pb[part * 64 + e] = base;
    }
    for (int a = tid; a < NA; a += NTHR) l_eid[a] = c.EID()[vcu * NA + a];
    __syncthreads();
    int my_nt = 0;
    if (tid < NE) { int tot = 0, base = 0;
#pragma unroll
        for (int p = 0; p < 8; ++p) { tot += l_pt[p * 64 + tid]; base += l_pb[p * 64 + tid]; }
        my_nt = (tot + PTILE - 1) / PTILE;
        l_cnt[tid] = my_nt; l_base[tid] = base; l_pt[tid] = 0; }
    __syncthreads();
    if (tid < NE) {
        int off = 0;
#pragma unroll
        for (int e = 0; e < NE; ++e) { const int v = l_cnt[e]; off += (e < tid) ? v : 0; }
        l_poff[tid] = off * PTILE;
        if (vcu == 0) { for (int i = 0; i < my_nt; ++i) c.TILEE()[off + i] = tid; if (tid == NE - 1) c.META()[0] = off + my_nt; }
    }
    __syncthreads();
    for (int a = tid; a < NA; a += NTHR) {
        const int e = l_eid[a];
        const int rank = __hip_atomic_fetch_add(&l_pt[e], 1, __ATOMIC_RELAXED, __HIP_MEMORY_SCOPE_WORKGROUP);
        const int dst = l_poff[e] + l_base[e] + rank;
        l_dest[a] = dst; c.DEST()[vcu * NA + a] = dst;
    }
    __syncthreads();
    for (int a = tid; a < NA; a += NTHR) { const int t = vcu * TPB + (a >> 1); c.SRC()[l_dest[a]] = t; c.RS()[l_dest[a]] = c.RSTD()[t]; }
}

__device__ __forceinline__ void ph_combine(const Ctx& c, int layer, int vcu, int nb, int wv) {
    const int tid = opaque_tid(wv);
    const int lane = tid & 63, wave = tid >> 6;
    const int gw = vcu * NWAVES + wave, ngw = nb * NWAVES;
    const bool last = (layer == DEPTH - 1);
    const float* gain = last ? c.norm_final_g : c.norm_mix_g + (size_t)(layer + 1) * D;
    f32x4 gn[4];
#pragma unroll
    for (int j = 0; j < 4; ++j) gn[j] = ((const f32x4*)gain)[lane + 64 * j];
    const int tpb = T / nb;
    for (int t0 = vcu * tpb + wave * 4; t0 < (vcu + 1) * tpb; t0 += NWAVES * 4) {
        int d0[4], d1[4]; float w0[4], w1[4];
#pragma unroll
        for (int q = 0; q < 4; ++q) { d0[q] = c.DEST()[2 * (t0 + q)]; d1[q] = c.DEST()[2 * (t0 + q) + 1]; w0[q] = c.CW()[2 * (t0 + q)]; w1[q] = c.CW()[2 * (t0 + q) + 1]; }
        f32x4 h[4][4]; u32x2 ya[4][4], yb[4][4];
#pragma unroll
        for (int q = 0; q < 4; ++q)
#pragma unroll
            for (int j = 0; j < 4; ++j) {
                { const u32x2 hv = ((const u32x2*)(c.H() + (size_t)(t0 + q) * D))[lane + 64 * j];
                  h[q][j].x = __uint_as_float(hv.x << 16); h[q][j].y = __uint_as_float(hv.x & 0xffff0000u); h[q][j].z = __uint_as_float(hv.y << 16); h[q][j].w = __uint_as_float(hv.y & 0xffff0000u); }
                ya[q][j] = ((const u32x2*)(c.YPAD() + (size_t)d0[q] * D))[lane + 64 * j];
                yb[q][j] = ((const u32x2*)(c.YPAD() + (size_t)d1[q] * D))[lane + 64 * j];
            }
#pragma unroll
        for (int q = 0; q < 4; ++q) {
            float s = 0.f;
#pragma unroll
            for (int j = 0; j < 4; ++j) {
                const u32x2 a = ya[q][j], b = yb[q][j]; f32x4 o = h[q][j];
                o.x += w0[q] * __uint_as_float(a.x << 16) + w1[q] * __uint_as_float(b.x << 16);
                o.y += w0[q] * __uint_as_float(a.x & 0xffff0000u) + w1[q] * __uint_as_float(b.x & 0xffff0000u);
                o.z += w0[q] * __uint_as_float(a.y << 16) + w1[q] * __uint_as_float(b.y << 16);
                o.w += w0[q] * __uint_as_float(a.y & 0xffff0000u) + w1[q] * __uint_as_float(b.y & 0xffff0000u);
                h[q][j] = o; s += (o.x * o.x + o.y * o.y) + (o.z * o.z + o.w * o.w);
            }
            const float r = rsqrtf(wave_sum(s) * (1.f / D) + EPS);
            if (!last) {
                u32x2* hw = (u32x2*)(c.H() + (size_t)(t0 + q) * D) + lane;
#pragma unroll
                for (int j = 0; j < 4; ++j) { u32x2 hv; hv.x = pk2(h[q][j].x, h[q][j].y); hv.y = pk2(h[q][j].z, h[q][j].w); hw[64 * j] = hv; }
                if (lane == 0) c.RSTDM()[t0 + q] = r;
            } else {
                f32x4* o = (f32x4*)(c.out + (size_t)(t0 + q) * D) + lane;
#pragma unroll
                for (int j = 0; j < 4; ++j) { f32x4 w; w.x = h[q][j].x * r * gn[j].x; w.y = h[q][j].y * r * gn[j].y; w.z = h[q][j].z * r * gn[j].z; w.w = h[q][j].w * r * gn[j].w; o[64 * j] = w; }
            }
        }
    }
}


__device__ __forceinline__ void unpack8(const u32x4 w, float (&f)[8]) {
    f[0] = __uint_as_float(w.x << 16); f[1] = __uint_as_float(w.x & 0xffff0000u); f[2] = __uint_as_float(w.y << 16); f[3] = __uint_as_float(w.y & 0xffff0000u);
    f[4] = __uint_as_float(w.z << 16); f[5] = __uint_as_float(w.z & 0xffff0000u); f[6] = __uint_as_float(w.w << 16); f[7] = __uint_as_float(w.w & 0xffff0000u);
}
__device__ __forceinline__ void ph_pool(const Ctx& c, int vcu, int nb, LAS unsigned char* lds, int wv) {
    const int tid = opaque_tid(wv);
    const bf16_t* P = c.PROJ();
    const int cg = tid & 63, tq = tid >> 6, hw = 1 << (cg >> 4);
    for (int tile = vcu; tile < T / 64; tile += nb) {
        const int t0 = tile * 64, b = t0 / SEQ, i0 = t0 % SEQ;
        __syncthreads();
#pragma unroll
        for (int k = 0; k < 10; ++k) {
            const int idx = tid + NTHR * k, row = idx >> 6, ch = idx & 63, pos = i0 - 8 + row;
            u32x4 v = {0u, 0u, 0u, 0u};
            if (pos >= 0 && pos < SEQ) v = *(const u32x4*)(P + (size_t)(b * SEQ + pos) * NIN + COL_U + ch * 8);
            *(LAS u32x4*)(lds + row * 1024 + ch * 16) = v;
        }
        __syncthreads();
        LAS const unsigned char* col = lds + cg * 16;
        const int r0 = 8 * tq + 8;
        float S[8], f[8];
#pragma unroll
        for (int e = 0; e < 8; ++e) S[e] = 0.f;
#pragma unroll
        for (int q = 0; q < 16; ++q) {
            unpack8(*(LAS const u32x4*)(col + (r0 - hw + q) * 1024), f);
            const float on = (q < 2 * hw) ? 1.f : 0.f;
#pragma unroll
            for (int e = 0; e < 8; ++e) S[e] += on * f[e];
        }
        bf16_t* outp = c.A2() + (size_t)(t0 + 8 * tq) * A2W + AOW + 8 * cg;
#pragma unroll
        for (int jt = 0; jt < 8; ++jt) {
            const int pos = i0 + 8 * tq + jt, lo = max(pos - hw, 0), hi = min(pos + hw, SEQ);
            const float inv = 1.0f / (float)(hi - lo);
            unpack8(*(LAS const u32x4*)(col + (r0 + jt) * 1024), f);
            u32x4 w; w.x = pk2(S[0] * inv - f[0], S[1] * inv - f[1]); w.y = pk2(S[2] * inv - f[2], S[3] * inv - f[3]); w.z = pk2(S[4] * inv - f[4], S[5] * inv - f[5]); w.w = pk2(S[6] * inv - f[6], S[7] * inv - f[7]);
            *(u32x4*)(outp + (size_t)jt * A2W) = w;
            if (jt < 7) {
                float a[8], d[8]; unpack8(*(LAS const u32x4*)(col + (r0 + jt + hw) * 1024), a); unpack8(*(LAS const u32x4*)(col + (r0 + jt - hw) * 1024), d);
#pragma unroll
                for (int e = 0; e < 8; ++e) S[e] += a[e] - d[e];
            }
        }
    }
}

typedef short bf16x8_t __attribute__((ext_vector_type(8)));
typedef short s16x4_t __attribute__((ext_vector_type(4)));
constexpr int AT_ROWB = 160;
constexpr int AT_KOFF = 0, AT_VOFF = 192 * AT_ROWB, AT_BIAS = 2 * 192 * AT_ROWB, AT_SLOT = AT_BIAS + 1024;
constexpr int NUNITS = NB_ * 3 * HPG * 32;
static_assert(2 * AT_SLOT <= 131072, "attention LDS");
__device__ __forceinline__ s16x4_t lds_tr16(LAS const unsigned char* p) { return __builtin_bit_cast(s16x4_t, __builtin_amdgcn_ds_read_tr16_b64_v4i16((LAS s16x4_t*)p)); }

struct AttnUnit { size_t tok0; int dil, L, blk, nblk, gi, hh, head; };
__device__ __forceinline__ AttnUnit attn_decode(int u) {
    AttnUnit a; const int b = u / 384, rem = u % 384; a.gi = rem >> 7; a.hh = (rem >> 5) & 3; const int rb = rem & 31;
    const int dsh = 2 * a.gi; a.dil = 1 << dsh; a.L = SEQ >> dsh; a.nblk = a.L >> 6;
    const int r = rb / a.nblk; a.blk = rb % a.nblk; a.head = a.gi * HPG + a.hh; a.tok0 = (size_t)b * SEQ + r; return a;
}
__device__ __forceinline__ void ph_attention(const Ctx& c, int vcu, int nb, LAS unsigned char* lds, int wv) {
    const int tid = opaque_tid(wv);
    const int wave = __builtin_amdgcn_readfirstlane(tid >> 6), lane = tid & 63, half = wave >> 2, wq = wave & 3, ht = tid & 255;
    const int g = lane >> 4, cq = lane & 15;
    LAS unsigned char* slot = lds + half * AT_SLOT;
    LAS float* lbias = (LAS float*)(slot + AT_BIAS);
    const bf16_t* P = c.PROJ();
    constexpr float LOG2E = 1.4426950408889634f, QSC = 0.125f * LOG2E;
    u32x4 rk[6], rv[6]; bf16x8_t rq0, rq1; float rb = 0.f;
    AttnUnit un = attn_decode(0);
    auto issue = [&](const AttnUnit& a) {
#pragma unroll
        for (int i = 0; i < 6; ++i) {
            const int idx = ht + 256 * i, row = idx >> 3, ch = idx & 7, lk = 64 * a.blk - 64 + row;
            rk[i] = (u32x4){0u, 0u, 0u, 0u}; rv[i] = (u32x4){0u, 0u, 0u, 0u};
            if (lk >= 0 && lk < a.L) { const bf16_t* rp = P + (a.tok0 + (size_t)a.dil * lk) * NIN + a.head * HD + ch * 8; rk[i] = *(const u32x4*)(rp + COL_K); rv[i] = *(const u32x4*)(rp + COL_V); }
        }
        { const bf16_t* qp = P + (a.tok0 + (size_t)a.dil * (64 * a.blk + 16 * wq + cq)) * NIN + a.head * HD + 8 * g; rq0 = *(const bf16x8_t*)qp; rq1 = *(const bf16x8_t*)(qp + 32); }
        if (ht < 160) { const int rel = ht - 80; rb = (rel >= -64 && rel <= 64) ? c.rel_bias[t5_bucket(a.dil * rel) * NH + a.head] * LOG2E : -1e30f; }
    };
    const bool bl_ = (nb == 256);
    auto pair_of = [&](int it) -> int { return bl_ ? ((it < 6) ? (vcu >> 5) * 192 + it * 32 + (vcu & 31) : NUNITS) : it * nb + vcu; };
    if (pair_of(0) * 2 < NUNITS) { un = attn_decode(pair_of(0) * 2 + half); issue(un); }
    for (int it = 0;; ++it) {
        const int pair = pair_of(it);
        if (pair * 2 >= NUNITS) break;
        const AttnUnit a = un;
#pragma unroll
        for (int i = 0; i < 6; ++i) {
            const int idx = ht + 256 * i, row = idx >> 3, ch = idx & 7;
            *(LAS u32x4*)(slot + AT_KOFF + row * AT_ROWB + ch * 16) = rk[i];
            *(LAS u32x4*)(slot + AT_VOFF + row * AT_ROWB + ch * 16) = rv[i];
        }
        if (ht < 160) lbias[ht] = rb;
        const bf16x8_t qf0 = rq0, qf1 = rq1;
        __syncthreads();
        { const int np = pair_of(it + 1); if (np * 2 < NUNITS) { un = attn_decode(np * 2 + half); issue(un); } }
        f32x4 sc[9];
#pragma unroll
        for (int t = 0; t < 9; ++t) {
            LAS const unsigned char* kp = slot + AT_KOFF + (16 * (wq + t) + cq) * AT_ROWB + 16 * g;
            const bf16x8_t a0 = *(LAS const bf16x8_t*)kp, a1 = *(LAS const bf16x8_t*)(kp + 64);
            f32x4 z = {0.f, 0.f, 0.f, 0.f};
            z = __builtin_amdgcn_mfma_f32_16x16x32_bf16(a0, qf0, z, 0, 0, 0);
            sc[t] = __builtin_amdgcn_mfma_f32_16x16x32_bf16(a1, qf1, z, 0, 0, 0);
        }
        LAS const float* bl = lbias + (16 + 4 * g - cq);
        float m = -1e30f;
#pragma unroll
        for (int t = 0; t < 9; ++t) {
            const bool dead = (a.blk == 0 && wq + t < 4) || (a.blk == a.nblk - 1 && wq + t >= 8);
#pragma unroll
            for (int j = 0; j < 4; ++j) { float v = sc[t][j] * QSC + bl[16 * t + j]; v = dead ? -1e30f : v; sc[t][j] = v; m = fmaxf(m, v); }
        }
        m = fmaxf(m, swz_xor<16>(m)); m = max_x32(m);
        float den = 0.f;
#pragma unroll
        for (int t = 0; t < 9; ++t)
#pragma unroll
            for (int j = 0; j < 4; ++j) { const float p = __builtin_amdgcn_exp2f(sc[t][j] - m); sc[t][j] = p; den += p; }
        den += swz_xor<16>(den); den = sum_x32(den);
        f32x4 o[4];
#pragma unroll
        for (int dt = 0; dt < 4; ++dt) o[dt] = (f32x4){0.f, 0.f, 0.f, 0.f};
#pragma unroll
        for (int ks = 0; ks < 5; ++ks) {
            const int t0 = 2 * ks, t1 = (2 * ks + 1 < 9) ? 2 * ks + 1 : 2 * ks;
            u32x4 pw;
            pw.x = pk2(sc[t0][0], sc[t0][1]); pw.y = pk2(sc[t0][2], sc[t0][3]);
            if (2 * ks + 1 < 9) { pw.z = pk2(sc[t1][0], sc[t1][1]); pw.w = pk2(sc[t1][2], sc[t1][3]); } else { pw.z = 0u; pw.w = 0u; }
            const bf16x8_t pa = __builtin_bit_cast(bf16x8_t, pw);
            LAS const unsigned char* v0 = slot + AT_VOFF + (16 * (wq + t0) + 4 * g + (cq >> 2)) * AT_ROWB + 8 * (cq & 3);
            LAS const unsigned char* v1 = slot + AT_VOFF + (16 * (wq + t1) + 4 * g + (cq >> 2)) * AT_ROWB + 8 * (cq & 3);
#pragma unroll
            for (int dt = 0; dt < 4; ++dt) {
                const s16x4_t b0 = lds_tr16(v0 + 32 * dt), b1 = lds_tr16(v1 + 32 * dt);
                const bf16x8_t bb = __builtin_shufflevector(b0, b1, 0, 1, 2, 3, 4, 5, 6, 7);
                o[dt] = __builtin_amdgcn_mfma_f32_16x16x32_bf16(pa, bb, o[dt], 0, 0, 0);
            }
        }
        bf16_t* og = c.OG() + (size_t)a.gi * T * AOW;
        const int lq0 = 64 * a.blk + 16 * wq;
#pragma unroll
        for (int j = 0; j < 4; ++j) {
            const float inv = __builtin_amdgcn_rcpf(__int_as_float(__builtin_amdgcn_ds_bpermute((4 * g + j) << 2, __float_as_int(den))));
            bf16_t* op = og + (a.tok0 + (size_t)a.dil * (lq0 + 4 * g + j)) * AOW + a.hh * HD + cq;
            const unsigned w01 = pk2(o[0][j] * inv, o[1][j] * inv), w23 = pk2(o[2][j] * inv, o[3][j] * inv);
            op[0] = (bf16_t)(w01 & 0xffffu); op[16] = (bf16_t)(w01 >> 16); op[32] = (bf16_t)(w23 & 0xffffu); op[48] = (bf16_t)(w23 >> 16);
        }
        if (g == 0) c.LSE()[((size_t)a.gi * T + a.tok0 + (size_t)a.dil * (lq0 + cq)) * HPG + a.hh] = (m + __builtin_amdgcn_logf(den)) * 0.6931471805599453f;
        __syncthreads();
    }
}
__device__ __forceinline__ void ph_merge64(const Ctx& c, int t_lo, int wv) {
    const int tid = opaque_tid(wv);
    const unsigned long long ab_u = (unsigned long long)(uintptr_t)c.A2();
    const unsigned ab_lo = (unsigned)__builtin_amdgcn_readfirstlane((unsigned)ab_u), ab_hi = (unsigned)__builtin_amdgcn_readfirstlane((unsigned)(ab_u >> 32));
    const __amdgpu_buffer_rsrc_t ars = __builtin_amdgcn_make_buffer_rsrc((void*)(uintptr_t)(((unsigned long long)ab_hi << 32) | ab_lo), (short)0, (int)((size_t)T * A2W * 2), 0x00020000);
#pragma unroll
    for (int it = 0; it < 4; ++it) {
        const int idx = it * NTHR + tid;
        const int t = t_lo + (idx >> 5), ch = idx & 31, hh = ch >> 3;
        const float l0 = c.LSE()[((size_t)0 * T + t) * HPG + hh], l1 = c.LSE()[((size_t)1 * T + t) * HPG + hh], l2 = c.LSE()[((size_t)2 * T + t) * HPG + hh];
        const float mm = fmaxf(fmaxf(l0, l1), l2);
        float e0 = __expf(l0 - mm), e1 = __expf(l1 - mm), e2 = __expf(l2 - mm);
        const float inv = 1.0f / (e0 + e1 + e2); e0 *= inv; e1 *= inv; e2 *= inv;
        const u32x4 a = *(const u32x4*)(c.OG() + ((size_t)0 * T + t) * AOW + ch * 8), b = *(const u32x4*)(c.OG() + ((size_t)1 * T + t) * AOW + ch * 8), d = *(const u32x4*)(c.OG() + ((size_t)2 * T + t) * AOW + ch * 8);
        u32x4 w;
        w.x = pk2(e0 * __uint_as_float(a.x << 16) + e1 * __uint_as_float(b.x << 16) + e2 * __uint_as_float(d.x << 16), e0 * __uint_as_float(a.x & 0xffff0000u) + e1 * __uint_as_float(b.x & 0xffff0000u) + e2 * __uint_as_float(d.x & 0xffff0000u));
        w.y = pk2(e0 * __uint_as_float(a.y << 16) + e1 * __uint_as_float(b.y << 16) + e2 * __uint_as_float(d.y << 16), e0 * __uint_as_float(a.y & 0xffff0000u) + e1 * __uint_as_float(b.y & 0xffff0000u) + e2 * __uint_as_float(d.y & 0xffff0000u));
        w.z = pk2(e0 * __uint_as_float(a.z << 16) + e1 * __uint_as_float(b.z << 16) + e2 * __uint_as_float(d.z << 16), e0 * __uint_as_float(a.z & 0xffff0000u) + e1 * __uint_as_float(b.z & 0xffff0000u) + e2 * __uint_as_float(d.z & 0xffff0000u));
        w.w = pk2(e0 * __uint_as_float(a.w << 16) + e1 * __uint_as_float(b.w << 16) + e2 * __uint_as_float(d.w << 16), e0 * __uint_as_float(a.w & 0xffff0000u) + e1 * __uint_as_float(b.w & 0xffff0000u) + e2 * __uint_as_float(d.w & 0xffff0000u));
        __builtin_amdgcn_raw_buffer_store_b128(w, ars, (int)(((unsigned)t * A2W + ch * 8) * 2u), 0, 16);
    }
}

namespace pg8 {
#define PG8_LAS __attribute__((address_space(3)))
typedef unsigned short bf16_t;
typedef short bf16x8 __attribute__((ext_vector_type(8)));
typedef float f32x4 __attribute__((ext_vector_type(4)));
typedef unsigned u32x4 __attribute__((ext_vector_type(4)));
constexpr int BM = 256, BK = 64, HALF = 128, HTB = HALF * BK * 2  , STAGE_BYTES = 8 * HTB, NXCD = 8, WGM = 8;

__host__ __device__ __forceinline__ int lds_byte(int r, int c) { const int st = (r >> 4) * 2 + (c >> 5), rr = r & 15, cc = c & 31, ob = rr * 64 + cc * 2; return st * 1024 + (ob ^ (((ob >> 9) & 1) << 5)); }
__host__ __device__ __forceinline__ void stage_rc(int b, int& R, int& C) { const int st = b / 1024, sb = b % 1024, swz = sb ^ (((sb >> 9) & 1) << 5); R = (st >> 1) * 16 + swz / 64; C = (st & 1) * 32 + (swz % 64) / 2; }
__host__ __device__ __forceinline__ int perm32(int rho) { const int n = rho >> 4, i = rho & 15; return 8 * (i >> 2) + 4 * n + (i & 3); }

struct Unit { int pm, pn, pb; };
struct Gemm { const bf16_t* A; const bf16_t* Bt; int M, N, K; };

struct StaticOrder {
    int nM, nN, nwg, G, c;
    __host__ __device__ void init(int M, int N, int G_, int c_) { nM = M / BM; nN = N / BM; nwg = nM * nN; G = G_; c = c_; }
    __host__ __device__ bool next(int i, Unit& u) const {
        const long L = (long)i * G + c; if (L >= nwg) return false;
        int wgid = (int)L; { const int q = nwg / NXCD, r = nwg % NXCD, xcd = wgid % NXCD, off = wgid / NXCD; wgid = (xcd < r ? xcd * (q + 1) : r * (q + 1) + (xcd - r) * q) + off; }
        const int nig = WGM * nN, gid = wgid / nig, fm = gid * WGM, gsz = (nM - fm) < WGM ? (nM - fm) : WGM;
        u.pm = fm + ((wgid % nig) % gsz); u.pn = (wgid % nig) / gsz; u.pb = u.pn; return true;
    }
    __device__ __forceinline__ void a_ready(const Unit&) const {}
    __device__ __forceinline__ void done(const Unit&) const {}
};


__device__ __forceinline__ unsigned cvt_pk_bf16(float lo, float hi) { unsigned r; asm volatile("v_cvt_pk_bf16_f32 %0, %1, %2" : "=v"(r) : "v"(lo), "v"(hi)); return r; }
__device__ __forceinline__ float bflo(unsigned w) { return __uint_as_float(w << 16); }
__device__ __forceinline__ float bfhi(unsigned w) { return __uint_as_float(w & 0xffff0000u); }
__device__ __forceinline__ float fsig(float v) { return __builtin_amdgcn_rcpf(1.0f + __expf(-v)); }
__device__ __forceinline__ u32x4 pack8(const f32x4& a, const f32x4& b) { u32x4 w; w.x = cvt_pk_bf16(a[0], a[1]); w.y = cvt_pk_bf16(a[2], a[3]); w.z = cvt_pk_bf16(b[0], b[1]); w.w = cvt_pk_bf16(b[2], b[3]); return w; }

struct EpiProj {
    static constexpr bool PERM = true, AFTER_DRAIN = false; static constexpr int MID_T = 0;
    bf16_t* P; const float* rs;
    __device__ __forceinline__ void mid(f32x4 (&)[2][2][4][2], const Unit&, int, int, int, int) const {}
    __device__ __forceinline__ void operator()(const f32x4 (&acc)[2][2][4][2], const Unit& u, int wr, int wc, int fr, int fq) const {
        const int row0 = u.pm * BM + wr * 64 + fr, col0 = u.pn * BM + wc * 32 + 8 * fq; const bool gate = (u.pn * BM >= COL_G);
        float rv[2][4];
#pragma unroll
        for (int ai = 0; ai < 2; ++ai)
#pragma unroll
            for (int m = 0; m < 4; ++m) rv[ai][m] = rs[row0 + ai * HALF + m * 16];
#pragma unroll
        for (int ai = 0; ai < 2; ++ai)
#pragma unroll
            for (int m = 0; m < 4; ++m) { bf16_t* rowp = P + (size_t)(row0 + ai * HALF + m * 16) * NIN + col0;
#pragma unroll
                for (int bj = 0; bj < 2; ++bj) { f32x4 v0 = acc[ai][bj][m][0] * rv[ai][m], v1 = acc[ai][bj][m][1] * rv[ai][m];
                    if (gate) {
#pragma unroll
                        for (int i = 0; i < 4; ++i) { v0[i] = fsig(v0[i]); v1[i] = fsig(v1[i]); } }
                    *(u32x4*)(rowp + bj * HALF) = pack8(v0, v1); } }
    }
};
struct EpiGate {
    static constexpr bool PERM = true, AFTER_DRAIN = false; static constexpr int MID_T = AOW / BK;
    const bf16_t* P; bf16_t* Y;
    __device__ __forceinline__ void mid(f32x4 (&acc)[2][2][4][2], const Unit& u, int wr, int wc, int fr, int fq) const {
        int row0 = u.pm * BM + wr * 64 + fr, col0 = u.pn * BM + wc * 32 + 8 * fq;
        asm volatile("" : "+v"(row0), "+v"(col0));
#pragma unroll
        for (int ai = 0; ai < 2; ++ai) {
            u32x4 ga[4][2], gb[4][2];
#pragma unroll
            for (int m = 0; m < 4; ++m) { const bf16_t* gp = P + (size_t)(row0 + ai * HALF + m * 16) * NIN + COL_G + col0;
#pragma unroll
                for (int bj = 0; bj < 2; ++bj) { ga[m][bj] = *(const u32x4*)(gp + bj * HALF); gb[m][bj] = *(const u32x4*)(gp + D + bj * HALF); } }
#pragma unroll
            for (int m = 0; m < 4; ++m)
#pragma unroll
                for (int bj = 0; bj < 2; ++bj) { const u32x4 a = ga[m][bj], b = gb[m][bj];
                    f32x4& v0 = acc[ai][bj][m][0]; f32x4& v1 = acc[ai][bj][m][1];
                    v0[0] *= bflo(a.x) * __builtin_amdgcn_rcpf(fmaxf(bflo(b.x), 1e-30f)); v0[1] *= bfhi(a.x) * __builtin_amdgcn_rcpf(fmaxf(bfhi(b.x), 1e-30f));
                    v0[2] *= bflo(a.y) * __builtin_amdgcn_rcpf(fmaxf(bflo(b.y), 1e-30f)); v0[3] *= bfhi(a.y) * __builtin_amdgcn_rcpf(fmaxf(bfhi(b.y), 1e-30f));
                    v1[0] *= bflo(a.z) * __builtin_amdgcn_rcpf(fmaxf(bflo(b.z), 1e-30f)); v1[1] *= bfhi(a.z) * __builtin_amdgcn_rcpf(fmaxf(bfhi(b.z), 1e-30f));
                    v1[2] *= bflo(a.w) * __builtin_amdgcn_rcpf(fmaxf(bflo(b.w), 1e-30f)); v1[3] *= bfhi(a.w) * __builtin_amdgcn_rcpf(fmaxf(bfhi(b.w), 1e-30f)); }
            asm volatile("" ::: "memory"); }
    }
    __device__ __forceinline__ void operator()(const f32x4 (&acc)[2][2][4][2], const Unit& u, int wr, int wc, int fr, int fq) const {
        const int row0 = u.pm * BM + wr * 64 + fr, col0 = u.pn * BM + wc * 32 + 8 * fq;
#pragma unroll
        for (int ai = 0; ai < 2; ++ai) {
            u32x4 gb[4][2];
#pragma unroll
            for (int m = 0; m < 4; ++m)
#pragma unroll
                for (int bj = 0; bj < 2; ++bj) gb[m][bj] = *(const u32x4*)(P + (size_t)(row0 + ai * HALF + m * 16) * NIN + COL_G + D + col0 + bj * HALF);
#pragma unroll
            for (int m = 0; m < 4; ++m) { bf16_t* yp = Y + (size_t)(row0 + ai * HALF + m * 16) * D + col0;
#pragma unroll
                for (int bj = 0; bj < 2; ++bj) { const u32x4 b = gb[m][bj]; f32x4 v0 = acc[ai][bj][m][0], v1 = acc[ai][bj][m][1];
                    v0[0] *= bflo(b.x); v0[1] *= bfhi(b.x); v0[2] *= bflo(b.y); v0[3] *= bfhi(b.y); v1[0] *= bflo(b.z); v1[1] *= bfhi(b.z); v1[2] *= bflo(b.w); v1[3] *= bfhi(b.w);
                    *(u32x4*)(yp + bj * HALF) = pack8(v0, v1); } }
            asm volatile("" ::: "memory"); }
    }
};
template <bool F32IN>
struct EpiRes {
    static constexpr bool PERM = true, AFTER_DRAIN = false; static constexpr int MID_T = 0;
    const float* basef; const bf16_t* baseh; bf16_t* Hh;
    __device__ __forceinline__ void mid(f32x4 (&)[2][2][4][2], const Unit&, int, int, int, int) const {}
    __device__ __forceinline__ void operator()(const f32x4 (&acc)[2][2][4][2], const Unit& u, int wr, int wc, int fr, int fq) const {
        const int row0 = u.pm * BM + wr * 64 + fr, col0 = u.pn * BM + wc * 32 + 8 * fq;
#pragma unroll
        for (int ai = 0; ai < 2; ++ai) {
            if constexpr (F32IN) {
                f32x4 rb[4][2][2];
#pragma unroll
                for (int m = 0; m < 4; ++m) { const size_t off = (size_t)(row0 + ai * HALF + m * 16) * D + col0;
#pragma unroll
                    for (int bj = 0; bj < 2; ++bj) { rb[m][bj][0] = *(const f32x4*)(basef + off + bj * HALF); rb[m][bj][1] = *(const f32x4*)(basef + off + bj * HALF + 4); } }
#pragma unroll
                for (int m = 0; m < 4; ++m) { const size_t off = (size_t)(row0 + ai * HALF + m * 16) * D + col0;
#pragma unroll
                    for (int bj = 0; bj < 2; ++bj) *(u32x4*)(Hh + off + bj * HALF) = pack8(rb[m][bj][0] + acc[ai][bj][m][0], rb[m][bj][1] + acc[ai][bj][m][1]); }
            } else {
                u32x4 rb[4][2];
#pragma unroll
                for (int m = 0; m < 4; ++m) { const size_t off = (size_t)(row0 + ai * HALF + m * 16) * D + col0;
#pragma unroll
                    for (int bj = 0; bj < 2; ++bj) rb[m][bj] = *(const u32x4*)(baseh + off + bj * HALF); }
#pragma unroll
                for (int m = 0; m < 4; ++m) { const size_t off = (size_t)(row0 + ai * HALF + m * 16) * D + col0;
#pragma unroll
                    for (int bj = 0; bj < 2; ++bj) { const u32x4 w = rb[m][bj]; f32x4 a0 = acc[ai][bj][m][0], a1 = acc[ai][bj][m][1];
                        a0.x += __uint_as_float(w.x << 16); a0.y += __uint_as_float(w.x & 0xffff0000u); a0.z += __uint_as_float(w.y << 16); a0.w += __uint_as_float(w.y & 0xffff0000u);
                        a1.x += __uint_as_float(w.z << 16); a1.y += __uint_as_float(w.z & 0xffff0000u); a1.z += __uint_as_float(w.w << 16); a1.w += __uint_as_float(w.w & 0xffff0000u);
                        *(u32x4*)(Hh + off + bj * HALF) = pack8(a0, a1); } }
            }
            asm volatile("" ::: "memory"); }
    }
};
struct EpiSilu {
    static constexpr bool PERM = true, AFTER_DRAIN = false; static constexpr int MID_T = 0;
    bf16_t* HBp;
    __device__ __forceinline__ void mid(f32x4 (&)[2][2][4][2], const Unit&, int, int, int, int) const {}
    __device__ __forceinline__ void operator()(const f32x4 (&acc)[2][2][4][2], const Unit& u, int wr, int wc, int fr, int fq) const {
        const int row0 = u.pm * BM + wr * 64 + fr, col0 = u.pn * HALF + wc * 32 + 8 * fq;
#pragma unroll
        for (int ai = 0; ai < 2; ++ai)
#pragma unroll
            for (int m = 0; m < 4; ++m) { f32x4 v0, v1;
#pragma unroll
                for (int i = 0; i < 4; ++i) { const float g0 = acc[ai][0][m][0][i], g1 = acc[ai][0][m][1][i]; v0[i] = g0 * fsig(g0) * acc[ai][1][m][0][i]; v1[i] = g1 * fsig(g1) * acc[ai][1][m][1][i]; }
                *(u32x4*)(HBp + (size_t)(row0 + ai * HALF + m * 16) * DE + col0) = pack8(v0, v1); }
    }
};
struct EpiBf16 {
    static constexpr bool PERM = true, AFTER_DRAIN = false; static constexpr int MID_T = 0;
    bf16_t* O; int ldc;
    __device__ __forceinline__ void mid(f32x4 (&)[2][2][4][2], const Unit&, int, int, int, int) const {}
    __device__ __forceinline__ void operator()(const f32x4 (&acc)[2][2][4][2], const Unit& u, int wr, int wc, int fr, int fq) const {
        const int row0 = u.pm * BM + wr * 64 + fr, col0 = u.pn * BM + wc * 32 + 8 * fq;
#pragma unroll
        for (int ai = 0; ai < 2; ++ai)
#pragma unroll
            for (int m = 0; m < 4; ++m) { bf16_t* rowp = O + (size_t)(row0 + ai * HALF + m * 16) * ldc + col0;
#pragma unroll
                for (int bj = 0; bj < 2; ++bj) *(u32x4*)(rowp + bj * HALF) = pack8(acc[ai][bj][m][0], acc[ai][bj][m][1]); }
    }
};
struct GroupedOrder {
    const int* tile_e; int ntot, G, vcu;
    __device__ void init(const int* te, int ntiles, int G_, int vcu_) { tile_e = te; ntot = ntiles * 4; G = G_; vcu = vcu_; }
    __device__ bool next(int i, Unit& u) const {
        const int L = i * G + vcu; if (L >= ntot) return false;
        u.pm = L >> 2; u.pn = L & 3; u.pb = __builtin_amdgcn_readfirstlane(__hip_atomic_load(tile_e + (L >> 2), __ATOMIC_RELAXED, __HIP_MEMORY_SCOPE_AGENT)) * 4 + (L & 3); return true;
    }
    __device__ __forceinline__ void a_ready(const Unit&) const {}
    __device__ __forceinline__ void done(const Unit&) const {}
};

template <class Epi, class Sched, bool ALIGN_EPI = false, bool SP2 = false>
__device__ __forceinline__ void gemm_phase(PG8_LAS unsigned char* lds, const Gemm g, const Sched& S, const Epi& E, int wv) {
    const int tid = opaque_tid(wv), wid = __builtin_amdgcn_readfirstlane(tid >> 6), lane = tid & 63, wr = wid >> 2, wc = wid & 3, fr = lane & 15, fq = lane >> 4;
    const int K = g.K, nt = K / BK;
    unsigned voffA[2], voffB[2];
#pragma unroll
    for (int i = 0; i < 2; ++i) { int R, C; stage_rc(tid * 16 + i * 8192, R, C); const int Rb = Epi::PERM ? ((R & ~31) + perm32(R & 31)) : R;
        voffA[i] = (unsigned)(R * K + C) * 2u; voffB[i] = (unsigned)(Rb * K + C) * 2u; }
    const size_t kstep = (size_t)(BK * 2);
    const size_t hstep = (size_t)HALF * K * 2;
    const size_t tstep = 2 * hstep;
    const unsigned ldsw = (unsigned)wid * 1024u;
    const int aoff = lds_byte(wr * 64 + fr, fq * 8), boff = lds_byte(wc * 32 + fr, fq * 8);
#define PG8_SA(b, h) (((b) * 2 + (h)) * HTB)
#define PG8_SB(b, h) ((4 + (b) * 2 + (h)) * HTB)
#define PG8_STAGE(bufoff, gbase, voff) do { _Pragma("unroll") for (int _i = 0; _i < 2; ++_i) \
        __builtin_amdgcn_global_load_lds((const unsigned*)((const char*)(gbase) + (voff)[_i]), (PG8_LAS unsigned*)(lds + (bufoff) + ldsw + _i * 8192), 16, 0, 0); } while (0)
#define PG8_LDA(dst, b, h) do { _Pragma("unroll") for (int m = 0; m < 4; ++m) _Pragma("unroll") for (int k = 0; k < 2; ++k) dst[m][k] = *(const PG8_LAS bf16x8*)(lds + PG8_SA(b, h) + aoff + m * 2048 + k * 1024); } while (0)
#define PG8_LDB(dst, b, h) do { _Pragma("unroll") for (int n = 0; n < 2; ++n) _Pragma("unroll") for (int k = 0; k < 2; ++k) dst[n][k] = *(const PG8_LAS bf16x8*)(lds + PG8_SB(b, h) + boff + n * 2048 + k * 1024); } while (0)
#define PG8_MMA(ai, bj, At, Bt) do { __builtin_amdgcn_s_setprio(1); _Pragma("unroll") for (int m = 0; m < 4; ++m) _Pragma("unroll") for (int n = 0; n < 2; ++n) _Pragma("unroll") for (int k = 0; k < 2; ++k) \
        acc[ai][bj][m][n] = __builtin_amdgcn_mfma_f32_16x16x32_bf16(Bt[n][k], At[m][k], acc[ai][bj][m][n], 0, 0, 0); __builtin_amdgcn_s_setprio(0); } while (0)
#define PG8_WAIT_V(n) asm volatile("s_waitcnt vmcnt(" #n ")" ::: "memory")
#define PG8_WAIT_L(n) asm volatile("s_waitcnt lgkmcnt(" #n ")" ::: "memory")
#define PG8_BAR __builtin_amdgcn_s_barrier()
#define PG8_SCHED __builtin_amdgcn_sched_barrier(0)
    Unit cur, nxt; int ui = 0;
    if (!S.next(0, cur)) return;
    f32x4 acc[2][2][4][2];
#pragma unroll
    for (int a = 0; a < 2; ++a)
#pragma unroll
        for (int b = 0; b < 2; ++b)
#pragma unroll
            for (int m = 0; m < 4; ++m)
#pragma unroll
                for (int n = 0; n < 2; ++n) acc[a][b][m][n] = (f32x4){0.f, 0.f, 0.f, 0.f};
    bf16x8 At[4][2], B0[2][2], B1[2][2];
    const char* cA = (const char*)g.A + (size_t)cur.pm * tstep; const char* cB = (const char*)g.Bt + (size_t)cur.pb * tstep;
    S.a_ready(cur);
    if constexpr (SP2) {
        PG8_STAGE(PG8_SB(0, 0), cB, voffB); PG8_STAGE(PG8_SB(0, 1), cB + hstep, voffB); PG8_STAGE(PG8_SA(0, 0), cA, voffA); PG8_STAGE(PG8_SA(0, 1), cA + hstep, voffA);
        if (wr == 1) PG8_BAR;
        PG8_WAIT_V(2); PG8_BAR;
        PG8_STAGE(PG8_SB(1, 0), cB + kstep, voffB); PG8_STAGE(PG8_SA(1, 0), cA + kstep, voffA); PG8_STAGE(PG8_SB(1, 1), cB + hstep + kstep, voffB);
        PG8_WAIT_V(6); PG8_BAR;
    } else {
        PG8_STAGE(PG8_SB(0, 0), cB, voffB); PG8_STAGE(PG8_SA(0, 0), cA, voffA); PG8_STAGE(PG8_SB(0, 1), cB + hstep, voffB); PG8_STAGE(PG8_SA(0, 1), cA + hstep, voffA);
        if (wr == 1) PG8_BAR;
        PG8_WAIT_V(4); PG8_BAR;
        PG8_STAGE(PG8_SB(1, 0), cB + kstep, voffB); PG8_STAGE(PG8_SA(1, 0), cA + kstep, voffA); PG8_STAGE(PG8_SB(1, 1), cB + hstep + kstep, voffB);
        PG8_WAIT_V(6); PG8_BAR;
    }
    for (;;) {
        const bool has_next = S.next(ui + 1, nxt);
        const char* nA = has_next ? (const char*)g.A + (size_t)nxt.pm * tstep : cA; const char* nB = has_next ? (const char*)g.Bt + (size_t)nxt.pb * tstep : cB;
        for (int t = 0; t < nt; t += 2) {
            const bool last = (t == nt - 2);
            const char* a1 = cA + (size_t)(t + 1) * kstep;
            const char* a2 = last ? nA : cA + (size_t)(t + 2) * kstep; const char* b2 = last ? nB : cB + (size_t)(t + 2) * kstep;
            const char* a3 = a2 + kstep; const char* b3 = b2 + kstep;
            if (last && has_next) S.a_ready(nxt);
            if constexpr (Epi::MID_T > 0) { if (t == Epi::MID_T) E.mid(acc, cur, wr, wc, fr, fq); }
            if constexpr (SP2) {
            PG8_LDB(B0, 0, 0); PG8_LDB(B1, 0, 1); PG8_SCHED; PG8_LDA(At, 0, 0); PG8_STAGE(PG8_SA(1, 1), a1 + hstep, voffA);
            PG8_WAIT_V(8); PG8_WAIT_L(0); PG8_BAR; PG8_MMA(0, 0, At, B0); PG8_MMA(0, 1, At, B1); PG8_BAR; PG8_SCHED;
            PG8_LDA(At, 0, 1); PG8_STAGE(PG8_SB(0, 0), b2, voffB); PG8_STAGE(PG8_SB(0, 1), b2 + hstep, voffB); PG8_STAGE(PG8_SA(0, 0), a2, voffA);
            PG8_WAIT_V(8); PG8_WAIT_L(0); PG8_BAR; PG8_MMA(1, 0, At, B0); PG8_MMA(1, 1, At, B1); PG8_BAR; PG8_SCHED;
            PG8_LDB(B0, 1, 0); PG8_LDB(B1, 1, 1); PG8_SCHED; PG8_LDA(At, 1, 0); PG8_STAGE(PG8_SA(0, 1), a2 + hstep, voffA);
            PG8_WAIT_V(8); PG8_WAIT_L(0); PG8_BAR; PG8_MMA(0, 0, At, B0); PG8_MMA(0, 1, At, B1); PG8_BAR; PG8_SCHED;
            PG8_LDA(At, 1, 1); PG8_STAGE(PG8_SB(1, 0), b3, voffB); PG8_STAGE(PG8_SB(1, 1), b3 + hstep, voffB); PG8_STAGE(PG8_SA(1, 0), a3, voffA);
            PG8_WAIT_V(8); PG8_WAIT_L(0); PG8_BAR; PG8_MMA(1, 0, At, B0); PG8_MMA(1, 1, At, B1); PG8_BAR; PG8_SCHED;
            } else {
            PG8_LDB(B0, 0, 0); PG8_SCHED; PG8_LDA(At, 0, 0); PG8_STAGE(PG8_SA(1, 1), a1 + hstep, voffA);
            PG8_WAIT_L(8); PG8_BAR; PG8_WAIT_L(0); PG8_MMA(0, 0, At, B0); PG8_BAR; PG8_SCHED;
            PG8_LDB(B1, 0, 1); PG8_STAGE(PG8_SB(0, 0), b2, voffB);
            PG8_BAR; PG8_WAIT_L(0); PG8_MMA(0, 1, At, B1); PG8_BAR;
            PG8_LDA(At, 0, 1); PG8_STAGE(PG8_SA(0, 0), a2, voffA);
            PG8_BAR; PG8_WAIT_L(0); PG8_MMA(1, 0, At, B0); PG8_BAR; PG8_SCHED;
            PG8_STAGE(PG8_SB(0, 1), b2 + hstep, voffB);
            PG8_WAIT_V(6); PG8_BAR; PG8_MMA(1, 1, At, B1); PG8_BAR;
            PG8_LDB(B0, 1, 0); PG8_SCHED; PG8_LDA(At, 1, 0); PG8_STAGE(PG8_SA(0, 1), a2 + hstep, voffA);
            PG8_WAIT_L(8); PG8_BAR; PG8_WAIT_L(0); PG8_MMA(0, 0, At, B0); PG8_BAR; PG8_SCHED;
            PG8_LDB(B1, 1, 1); PG8_STAGE(PG8_SB(1, 0), b3, voffB);
            PG8_BAR; PG8_WAIT_L(0); PG8_MMA(0, 1, At, B1); PG8_BAR;
            PG8_LDA(At, 1, 1); PG8_STAGE(PG8_SA(1, 0), a3, voffA);
            PG8_BAR; PG8_WAIT_L(0); PG8_MMA(1, 0, At, B0); PG8_BAR; PG8_SCHED;
            PG8_STAGE(PG8_SB(1, 1), b3 + hstep, voffB);
            PG8_WAIT_V(6); PG8_BAR; PG8_MMA(1, 1, At, B1); PG8_BAR;
            }
        }
        if constexpr (ALIGN_EPI) { if (wr == 0) PG8_BAR; }
        if constexpr (!Epi::AFTER_DRAIN) { E(acc, cur, wr, wc, fr, fq); S.done(cur); }
        if (!has_next) break;
#pragma unroll
        for (int a = 0; a < 2; ++a)
#pragma unroll
            for (int b = 0; b < 2; ++b)
#pragma unroll
                for (int m = 0; m < 4; ++m)
#pragma unroll
                    for (int n = 0; n < 2; ++n) acc[a][b][m][n] = (f32x4){0.f, 0.f, 0.f, 0.f};
        cur = nxt; cA = nA; cB = nB; ++ui;
        if constexpr (ALIGN_EPI) { if (wr == 1) PG8_BAR; }
    }
    PG8_WAIT_V(0);
    if constexpr (!ALIGN_EPI) { if (wr == 0) PG8_BAR; }
    PG8_BAR;
    if constexpr (Epi::AFTER_DRAIN) { E.fused(acc, cur, wr, wc, fr, fq, lds, wid, lane); S.done(cur); }
#undef PG8_SA
#undef PG8_SB
#undef PG8_STAGE
#undef PG8_LDA
#undef PG8_LDB
#undef PG8_MMA
#undef PG8_WAIT_V
#undef PG8_WAIT_L
#undef PG8_BAR
#undef PG8_SCHED
}
}


namespace moe {
typedef short bf16x8 __attribute__((ext_vector_type(8)));
typedef short s16x4 __attribute__((ext_vector_type(4)));
constexpr int BK = 64, TILE_B = 256 * BK * 2, STAGE_B = 2 * TILE_B;
__device__ __forceinline__ int lds_byte2(int r, int c) { const int st = (r >> 4) * 2 + (c >> 5), ob = (r & 15) * 64 + (c & 31) * 2; return st * 1024 + (ob ^ (((ob >> 9) & 1) << 5)); }
__device__ __forceinline__ void stage_rc2(int b, int& R, int& C) { const int st = b >> 10, sb = b & 1023, swz = sb ^ (((sb >> 9) & 1) << 5); R = (st / 2) * 16 + swz / 64; C = (st % 2) * 32 + (swz % 64) / 2; }
__device__ __forceinline__ void glds16_asm(const void* sbase, unsigned voff, unsigned lds_dst) { unsigned keep;
    asm volatile("s_mov_b32 %0, m0\n\ts_mov_b32 m0, %3\n\ts_nop 0\n\tglobal_load_lds_dwordx4 %1, %2\n\ts_mov_b32 m0, %0" : "=&s"(keep) : "v"(voff), "s"(sbase), "s"(lds_dst) : "memory"); }
__device__ __forceinline__ s16x4 tr16(LAS const unsigned char* p) { return __builtin_bit_cast(s16x4, __builtin_amdgcn_ds_read_tr16_b64_v4i16((LAS s16x4*)p)); }

template <int MODE>
__device__ __forceinline__ void gemm_phase(LAS unsigned char* lds, const bf16_t* A, int K, const float* W0, const float* W1, bf16_t* O, const int* tile_e, const int* src_map, const float* rstd, const float* kgain, int* ready, int ntiles, int G_, int vcu, int wv) {
    const int tid = opaque_tid(wv), wid = __builtin_amdgcn_readfirstlane(tid >> 6), lane = tid & 63, wr = wid >> 2, wc = wid & 3, fr = lane & 15, fq = lane >> 4;
    const int nt = K / BK, ntot = ntiles * 4;
    const unsigned lds0 = (unsigned)(uintptr_t)lds;
    LAS unsigned* avl = (LAS unsigned*)(lds + 2 * STAGE_B + 1024) + 4 * tid;
    constexpr int NW = (MODE == 0) ? DE : D;
    unsigned avoff = 0u; if (MODE == 1) { int R, C; stage_rc2(wid * 1024 + lane * 16, R, C); avoff = (unsigned)(R * K + C) * 2u; }
    const int krow = (MODE == 0) ? 2 * (wid >> 1) + (lane >> 5) : wid;
    const int hcol = 4 * (lane & 31);
    const int bcol = (MODE == 0) ? 64 * (hcol >> 5) + 32 * (wid & 1) + (hcol & 31) : 4 * lane;
    const unsigned wsrcb = (unsigned)((MODE == 0) ? (lane >> 5) * NW + hcol : 4 * lane) * 4u;
    const int c32 = bcol & 31, pos = (bcol & ~31) + 16 * ((c32 >> 2) & 1) + 4 * (c32 >> 3);
    const int bw_even = krow * 512 + ((pos * 2) ^ ((krow & 3) << 5)), bw_odd = krow * 512 + ((pos * 2) ^ (((krow & 3) | 4) << 5));
    const int aread0 = lds_byte2(wr * 128 + fr, fq * 8);
    const int tq = fr >> 2, tp = fr & 3, fx = (tq | ((fq & 1) << 2)) << 5;
    int bread[4];
#pragma unroll
    for (int n = 0; n < 4; ++n) bread[n] = (8 * fq + tq) * 512 + (((wc * 64 + 16 * n + 4 * tp) * 2) ^ fx);
    auto wait_ready = [&](int rt_) {
        if (opaque_tid(wv) == 0) {
            unsigned sp = 0;
            while (__hip_atomic_load(ready + rt_, __ATOMIC_RELAXED, __HIP_MEMORY_SCOPE_AGENT) < 4) { __builtin_amdgcn_s_sleep(2); if (++sp > (1u << 22)) break; }
            __builtin_amdgcn_fence(__ATOMIC_ACQUIRE, "agent");
            asm volatile("s_waitcnt vmcnt(0)" ::: "memory");
        }
        __syncthreads();
    };
    auto set_avl = [&](int rt_, int par_) {
        const int t2 = opaque_tid(wv); int R, C; stage_rc2((t2 >> 6) * 1024 + (t2 & 63) * 16, R, C);
        LAS unsigned* av = (LAS unsigned*)(lds + 2 * STAGE_B + 1024 + par_ * 8192) + 4 * t2;
#pragma unroll
        for (int i = 0; i < 4; ++i) av[i] = (unsigned)src_map[rt_ * 256 + R + 64 * i] * (unsigned)(K * 2) + (unsigned)C * 2u;
    };
    auto mk_wrs = [&](int e_, int ct_) -> __amdgpu_buffer_rsrc_t {
        const float* Wbase = (MODE == 0 ? ((wid & 1) ? W1 : W0) + (size_t)e_ * K * NW + ct_ * 128 + (size_t)(2 * (wid >> 1)) * NW : W0 + (size_t)e_ * K * NW + ct_ * 256 + (size_t)wid * NW);
        const unsigned long long wb_u = (unsigned long long)(uintptr_t)Wbase;
        const unsigned wb_lo = __builtin_amdgcn_readfirstlane((unsigned)wb_u), wb_hi = __builtin_amdgcn_readfirstlane((unsigned)(wb_u >> 32));
        return __builtin_amdgcn_make_buffer_rsrc((void*)(uintptr_t)(((unsigned long long)wb_hi << 32) | wb_lo), (short)0, (int)(K * NW * 4), 0x00020000);
    };
    int rt, ct;
    const int dn_a = ntot / G_, dn_rem = ntot - dn_a * G_, dn_n0 = G_ - dn_rem;
    auto unit_at = [&](int k) -> int {
        if (MODE == 0) { const int L = k * G_ + vcu; return L < ntot ? L : -1; }
        if (k < dn_a) return k * G_ + (G_ - 1 - vcu);
        int e = -1;
        if (vcu >= dn_rem) { const int w = G_ - 1 - vcu; if (k == dn_a) e = w; else if (k == dn_a + 1) e = dn_n0 + w; }
        else if (k == dn_a) e = 2 * dn_n0 + vcu;
        return (e >= 0 && e < dn_rem) ? dn_a * G_ + e : -1;
    };
    { const int L = unit_at(0); if (L < 0) return; rt = L >> 2; ct = L & 3; }
    if (MODE == 1) wait_ready(rt);
    int par = 0;
    if (MODE == 0) set_avl(rt, 0);
    __amdgpu_buffer_rsrc_t wrs = mk_wrs(__builtin_amdgcn_readfirstlane(__hip_atomic_load(tile_e + rt, __ATOMIC_RELAXED, __HIP_MEMORY_SCOPE_AGENT)), ct);
    const bf16_t* Ab = A + (size_t)rt * 256 * K;
    f32x4 acc[8][4];
    f32x4 rb[8]; float gv = 1.f;
#define MOE_SA(b) (lds + (b) * STAGE_B)
#define MOE_SB(b) (lds + (b) * STAGE_B + TILE_B)
#define MOE_GLDS_A(buf, kt, Abx, parx) do { u32x4 vo_ = {avoff, avoff, avoff, avoff}; if (MODE == 0) vo_ = *(LAS const u32x4*)((LAS unsigned*)(lds + 2 * STAGE_B + 1024 + (parx) * 8192) + 4 * opaque_tid(wv));     \
        _Pragma("unroll") for (int i = 0; i < 4; ++i) \
        glds16_asm((MODE == 0 ? A : (Abx) + (size_t)i * 64 * K) + (kt) * BK, vo_[i], (unsigned)__builtin_amdgcn_readfirstlane(lds0 + (buf) * STAGE_B + wid * 1024 + i * 8192)); } while (0)
#define MOE_ISSUE_B(rs_, kt) do { if (MODE == 0) gv = kgain[(kt) * BK + (opaque_tid(wv) & 63)];     \
        _Pragma("unroll") for (int q = 0; q < 8; ++q) rb[q] = __builtin_bit_cast(f32x4, __builtin_amdgcn_raw_buffer_load_b128(rs_, (int)wsrcb, (int)(((kt) * BK + 8 * q) * NW * 4), 0)); } while (0)
#define MOE_WRITE_B(buf, kt) do { const int l_ = opaque_tid(wv) & 63;     \
        const int kr_ = (MODE == 0) ? 2 * (wid >> 1) + (l_ >> 5) : wid, hc_ = 4 * (l_ & 31), bc_ = (MODE == 0) ? 64 * (hc_ >> 5) + 32 * (wid & 1) + (hc_ & 31) : 4 * l_; \
        const int c3_ = bc_ & 31, ps_ = (bc_ & ~31) + 16 * ((c3_ >> 2) & 1) + 4 * (c3_ >> 3); \
        const int be_ = kr_ * 512 + ((ps_ * 2) ^ ((kr_ & 3) << 5)), bo_ = be_ ^ 128; \
        float gq_[8]; if (MODE == 0) { _Pragma("unroll") for (int q = 0; q < 8; ++q) gq_[q] = __builtin_bit_cast(float, __builtin_amdgcn_ds_bpermute((8 * q + kr_) * 4, __builtin_bit_cast(int, gv))); }     \
        _Pragma("unroll") for (int q = 0; q < 8; ++q) { u32x2 w; \
            if (MODE == 0) { w.x = pk2(rb[q].x * gq_[q], rb[q].y * gq_[q]); w.y = pk2(rb[q].z * gq_[q], rb[q].w * gq_[q]); } else { w.x = pk2(rb[q].x, rb[q].y); w.y = pk2(rb[q].z, rb[q].w); } \
            *(LAS u32x2*)(MOE_SB(buf) + ((q & 1) ? bo_ : be_) + q * 4096) = w; } } while (0)
#define MOE_COMPUTE(cur) do { __builtin_amdgcn_sched_barrier(0); \
            _Pragma("unroll") for (int ks = 0; ks < 2; ++ks) { \
                bf16x8 Bf[4]; \
                _Pragma("unroll") for (int n = 0; n < 4; ++n) { const s16x4 b0 = tr16(MOE_SB(cur) + bread[n] + ks * 16384), b1 = tr16(MOE_SB(cur) + bread[n] + ks * 16384 + 2048); Bf[n] = __builtin_shufflevector(b0, b1, 0, 1, 2, 3, 4, 5, 6, 7); } \
                _Pragma("unroll") for (int mh = 0; mh < 2; ++mh) { bf16x8 At[4]; \
                    _Pragma("unroll") for (int m = 0; m < 4; ++m) At[m] = *(LAS const bf16x8*)(MOE_SA(cur) + aread0 + (4 * mh + m) * 2048 + ks * 1024); \
                    _Pragma("unroll") for (int m = 0; m < 4; ++m) _Pragma("unroll") for (int n = 0; n < 4; ++n) acc[4 * mh + m][n] = __builtin_amdgcn_mfma_f32_16x16x32_bf16(Bf[n], At[m], acc[4 * mh + m][n], 0, 0, 0); \
                    __builtin_amdgcn_sched_barrier(0); } } } while (0)
#define MOE_END8() do { asm volatile("s_waitcnt vmcnt(8) lgkmcnt(0)" ::: "memory"); __builtin_amdgcn_s_barrier(); } while (0)
#define MOE_END0() do { asm volatile("s_waitcnt vmcnt(0) lgkmcnt(0)" ::: "memory"); __builtin_amdgcn_s_barrier(); } while (0)
#define MOE_STEP(cur, t) do { int tt_ = (t); asm volatile("" : "+s"(tt_));     \
        const bool own1 = tt_ + 1 < nt, own2 = tt_ + 2 < nt; \
        if (own1 || hn) { MOE_WRITE_B(1 - (cur), (own1 ? tt_ + 1 : 0)); __builtin_amdgcn_sched_barrier(0); MOE_GLDS_A(1 - (cur), (own1 ? (t) + 1 : 0), (own1 ? Ab : nAb), (own1 ? par : (par ^ 1))); } \
        if (MODE == 1 && (cur) == 0 && hn && tt_ == nt - 2) wait_ready(nrt); \
        if (own2 || hn) MOE_ISSUE_B((own2 ? wrs : nwrs), (own2 ? (t) + 2 : (t) + 2 - nt)); \
        MOE_COMPUTE(cur); \
        if (own2 || hn) MOE_END8(); else MOE_END0(); } while (0)
    MOE_ISSUE_B(wrs, 0); MOE_WRITE_B(0, 0); MOE_GLDS_A(0, 0, Ab, 0); MOE_ISSUE_B(wrs, 1);
    MOE_END0();
    int pend = -1;
    for (int ui = 0;; ++ui) {
        const int Ln = unit_at(ui + 1);
        const bool hn = Ln >= 0;
        const int nrt = Ln >> 2, nct = Ln & 3;
        __amdgpu_buffer_rsrc_t nwrs = wrs; const bf16_t* nAb = Ab;
        if (hn) {
            nwrs = mk_wrs(__builtin_amdgcn_readfirstlane(__hip_atomic_load(tile_e + nrt, __ATOMIC_RELAXED, __HIP_MEMORY_SCOPE_AGENT)), nct);
            nAb = A + (size_t)nrt * 256 * K;
            if (MODE == 0) set_avl(nrt, par ^ 1);
        }
        float zf = 0.f; asm volatile("" : "+v"(zf));
#pragma unroll
        for (int m = 0; m < 8; ++m)
#pragma unroll
            for (int n = 0; n < 4; ++n) acc[m][n] = (f32x4){zf, zf, zf, zf};
        for (int t = 0; t < nt; t += 2) {
            MOE_STEP(0, t);
            int t0_ = t; asm volatile("" : "+s"(t0_));
            if (MODE == 0 && t0_ == 0 && pend >= 0) { if (opaque_tid(wv) == 0) __hip_atomic_fetch_add(ready + pend, 1, __ATOMIC_RELAXED, __HIP_MEMORY_SCOPE_AGENT); }
            MOE_STEP(1, t + 1);
        }
        const int tid_e = opaque_tid(wv), fr_e = tid_e & 15, fq_e = (tid_e >> 4) & 3;
        const int row0 = rt * 256 + wr * 128 + fr_e;
        if (MODE == 0) {
            const unsigned long long ob_u = (unsigned long long)(uintptr_t)O;
            const unsigned ob_lo = (unsigned)__builtin_amdgcn_readfirstlane((unsigned)ob_u), ob_hi = (unsigned)__builtin_amdgcn_readfirstlane((unsigned)(ob_u >> 32));
            const __amdgpu_buffer_rsrc_t ors = __builtin_amdgcn_make_buffer_rsrc((void*)(uintptr_t)(((unsigned long long)ob_hi << 32) | ob_lo), (short)0, (int)((size_t)PMAX * DE * 2), 0x00020000);
            const int col0 = ct * 128 + wc * 32 + 8 * fq_e;
            float rs[8];
#pragma unroll
            for (int m = 0; m < 8; ++m) rs[m] = rstd[row0 + m * 16];
#pragma unroll
            for (int m = 0; m < 8; ++m) { f32x4 v0, v1;
#pragma unroll
                for (int i = 0; i < 4; ++i) { const float g0 = acc[m][0][i] * rs[m], g1 = acc[m][1][i] * rs[m]; v0[i] = g0 * pg8::fsig(g0) * (acc[m][2][i] * rs[m]); v1[i] = g1 * pg8::fsig(g1) * (acc[m][3][i] * rs[m]); }
                __builtin_amdgcn_raw_buffer_store_b128(pg8::pack8(v0, v1), ors, (int)(((unsigned)(row0 + m * 16) * DE + col0) * 2u), 0, 16);
                __builtin_amdgcn_sched_barrier(0); }
            pend = rt;
        } else {
            const int col0 = ct * 256 + wc * 64 + 8 * fq_e;
#pragma unroll
            for (int m = 0; m < 8; ++m) { bf16_t* rp = O + (size_t)(row0 + m * 16) * D + col0;
                *(u32x4*)rp = pg8::pack8(acc[m][0], acc[m][1]); *(u32x4*)(rp + 32) = pg8::pack8(acc[m][2], acc[m][3]); __builtin_amdgcn_sched_barrier(0); }
        }
        if (!hn) break;
        rt = nrt; ct = nct; wrs = nwrs; Ab = nAb; par ^= 1;
    }
    if (MODE == 0) {
        asm volatile("s_waitcnt vmcnt(0)" ::: "memory"); __syncthreads();
        if (opaque_tid(wv) == 0) __hip_atomic_fetch_add(ready + pend, 1, __ATOMIC_RELAXED, __HIP_MEMORY_SCOPE_AGENT);
    }
#undef MOE_STEP
#undef MOE_END8
#undef MOE_END0
#undef MOE_COMPUTE
#undef MOE_SA
#undef MOE_SB
#undef MOE_GLDS_A
#undef MOE_ISSUE_B
#undef MOE_WRITE_B
}
}

__device__ __forceinline__ void transpose_item(const float* W, int ldw, int k0, int n0, bf16_t* WT, size_t drow0, int dk0, int ldk, LAS float* scr, int lane, const float* ksc = nullptr) {
    f32x4 v[16];
#pragma unroll
    for (int i = 0; i < 16; ++i) v[i] = *(const f32x4*)(W + (size_t)(k0 + 4 * i + (lane >> 4)) * ldw + n0 + 4 * (lane & 15));
    if (ksc) {
#pragma unroll
        for (int i = 0; i < 16; ++i) { const float s = ksc[k0 + 4 * i + (lane >> 4)]; v[i].x *= s; v[i].y *= s; v[i].z *= s; v[i].w *= s; } }
#pragma unroll
    for (int i = 0; i < 16; ++i) { const int kk = 4 * i + (lane >> 4), nb4 = 4 * (lane & 15);
#pragma unroll
        for (int e = 0; e < 4; ++e) scr[kk * 64 + ((nb4 + e + kk) & 63)] = v[i][e]; }
    asm volatile("s_waitcnt lgkmcnt(0)" ::: "memory");
    const int cch = lane & 7;
#pragma unroll
    for (int j = 0; j < 8; ++j) { const int n = (lane >> 3) + 8 * j; float f[8];
#pragma unroll
        for (int q = 0; q < 8; ++q) { const int kk = 8 * cch + q; f[q] = scr[kk * 64 + ((n + kk) & 63)]; }
        u32x4 o; o.x = pk2(f[0], f[1]); o.y = pk2(f[2], f[3]); o.z = pk2(f[4], f[5]); o.w = pk2(f[6], f[7]);
        *(u32x4*)(WT + (drow0 + n) * (size_t)ldk + dk0 + 8 * cch) = o; }
    asm volatile("s_waitcnt lgkmcnt(0)" ::: "memory");
}
__device__ __forceinline__ void ph_prologue(const Ctx& c, int vcu, int nb, LAS unsigned char* lds, int wv) {
    const int tid = opaque_tid(wv);
    const int lane = tid & 63, wave = __builtin_amdgcn_readfirstlane(tid >> 6);
    LAS float* scr = (LAS float*)(lds + wave * 16384);
    const int gw = vcu * NWAVES + wave, ngw = nb * NWAVES;
    constexpr int I_IN = (D / 64) * (NIN / 64), I_PA = (AOW / 64) * (D / 64), I_OUT = (D / 64) * (D / 64);
    constexpr int I_DENSE = DEPTH * (I_IN + I_PA + I_OUT);
    for (int it = gw; it < I_DENSE; it += ngw) {
        int r = it;
        if (r < I_DENSE) {
            const int l = r / (I_IN + I_PA + I_OUT); r -= l * (I_IN + I_PA + I_OUT);
            if (r < I_IN) { const int kb = r / (NIN / 64), nbk = r % (NIN / 64); transpose_item(c.w_in + (size_t)l * D * NIN, NIN, 64 * kb, 64 * nbk, c.WIN() + (size_t)l * NIN * D, 64 * nbk, 64 * kb, D, scr, lane, c.norm_mix_g + (size_t)l * D); continue; }
            r -= I_IN;
            if (r < I_PA) { const int kb = r / (D / 64), nbk = r % (D / 64); transpose_item(c.w_proj_attn + (size_t)l * AOW * D, D, 64 * kb, 64 * nbk, c.WP() + (size_t)l * D * A2W, 64 * nbk, 64 * kb, A2W, scr, lane); continue; }
            r -= I_PA;
            { const int kb = r / (D / 64), nbk = r % (D / 64); transpose_item(c.w_out + (size_t)l * D * D, D, 64 * kb, 64 * nbk, c.WOUT() + (size_t)l * D * D, 64 * nbk, 64 * kb, D, scr, lane); continue; }
        }
    }
    for (int it = gw; it < DEPTH * 160; it += ngw) {
        const int l = it / 160, f = it % 160, ks = f / 5, nt = f % 5, g = lane >> 4, n = 16 * nt + (lane & 15);
        float wv[8];
#pragma unroll
        for (int j = 0; j < 8; ++j) { const int k = 32 * ks + 8 * g + j; float w = 0.f;
            if (n < NEG) w = c.w_rg[((size_t)l * D + k) * NEG + n];
            else if (n < NEG + NE) w = c.w_re[(((size_t)l * NEG + ((n - NEG) >> 3)) * D + k) * EPG + ((n - NEG) & 7)];
            wv[j] = w * c.norm_ffn_g[(size_t)l * D + k]; }
        u32x4 h, lo;
        const unsigned h0 = f2bf(wv[0]), h1 = f2bf(wv[1]), h2 = f2bf(wv[2]), h3 = f2bf(wv[3]), h4 = f2bf(wv[4]), h5 = f2bf(wv[5]), h6 = f2bf(wv[6]), h7 = f2bf(wv[7]);
        h.x = h0 | (h1 << 16); h.y = h2 | (h3 << 16); h.z = h4 | (h5 << 16); h.w = h6 | (h7 << 16);
        lo.x = pk2(wv[0] - __uint_as_float(h0 << 16), wv[1] - __uint_as_float(h1 << 16)); lo.y = pk2(wv[2] - __uint_as_float(h2 << 16), wv[3] - __uint_as_float(h3 << 16));
        lo.z = pk2(wv[4] - __uint_as_float(h4 << 16), wv[5] - __uint_as_float(h5 << 16)); lo.w = pk2(wv[6] - __uint_as_float(h6 << 16), wv[7] - __uint_as_float(h7 << 16));
        u32x4* dst = (u32x4*)c.WR() + (size_t)l * 2 * WR_FRAGS;
        dst[f * 64 + lane] = h; dst[WR_FRAGS + f * 64 + lane] = lo;
    }
    ph_x_to_h(c.x, c.H(), c.RSTDM(), vcu, nb, wv);
    ph_fold_wpc(c, vcu, nb, wv);
}

#define XB_TMO      128
#define XB_XCNT(j)  (256  + 64 * (j))
#define XB_XSUB(j)  (1280 + 64 * (j))
#define XB_XGEN(j)  (2304 + 64 * (j))
#define XB_TOP      3328
#define XB_TOPGEN   3392
#define XCD_BAR_WORDS 3456
#define XB_SPIN_CAP (1u << 18)

__device__ __forceinline__ unsigned xb_ld(unsigned* p)              { return __hip_atomic_load(p, __ATOMIC_RELAXED, __HIP_MEMORY_SCOPE_AGENT); }
__device__ __forceinline__ unsigned xb_add(unsigned* p, unsigned v) { return __hip_atomic_fetch_add(p, v, __ATOMIC_RELAXED, __HIP_MEMORY_SCOPE_AGENT); }
__device__ __forceinline__ unsigned xb_xcc_id() { return (unsigned)__builtin_amdgcn_s_getreg((3 << 11) | 20) & 0xFu; }
#define XB_SPIN(cond, bar) do { unsigned _sp = 0; while (cond) { __builtin_amdgcn_s_sleep(1); \
    if ((++_sp & 255u) == 0u) { if (xb_ld(&(bar)[XB_TMO])) break; if (_sp > XB_SPIN_CAP) { atomicAdd(&(bar)[XB_TMO], 1u); break; } } } } while (0)

struct XcdBarrier {
    unsigned* bar; unsigned x;
    volatile LAS unsigned* st;
};

__device__ __forceinline__ XcdBarrier xcd_barrier_post(unsigned* bar, volatile LAS unsigned* st, bool t0) {
    XcdBarrier b; b.bar = bar; b.x = xb_xcc_id(); b.st = st;
    if (t0) st[2] = xb_add(&bar[XB_XCNT(b.x)], 1u);
    return b;
}
__device__ __forceinline__ void xcd_barrier_complete(unsigned* bar, unsigned x, unsigned& nloc, unsigned& nx) {
    const unsigned G = gridDim.x * gridDim.y * gridDim.z;
    unsigned sum, cnt, mine, sp = 0u;
    for (;;) {
        sum = 0u; cnt = 0u; mine = 0u;
#pragma unroll
        for (unsigned j = 0; j < 16; ++j) { const unsigned c = xb_ld(&bar[XB_XCNT(j)]); sum += c; cnt += (c > 0u) ? 1u : 0u; mine = (j == x) ? c : mine; }
        if (sum == G) break;
        __builtin_amdgcn_s_sleep(1);
        if ((++sp & 255u) == 0u) { if (xb_ld(&bar[XB_TMO])) break; if (sp > XB_SPIN_CAP) { atomicAdd(&bar[XB_TMO], 1u); break; } }
    }
    nloc = mine > 0u ? mine : 1u; nx = cnt > 0u ? cnt : 1u;
}

__device__ __forceinline__ void xcd_barrier(const XcdBarrier& b, bool t0, bool light = false) {
    asm volatile("s_waitcnt vmcnt(0)" ::: "memory");
    __syncthreads();
    if (t0) {
        unsigned* bar = b.bar;
        __builtin_amdgcn_s_waitcnt(0);
        unsigned nloc = b.st[0], nx = b.st[1];
        if (nloc == 0u) { xcd_barrier_complete(bar, b.x, nloc, nx); b.st[0] = nloc; b.st[1] = nx; }
        const unsigned old = xb_add(&bar[XB_XSUB(b.x)], 1u);
        const unsigned gen = old / nloc;
        if (old + 1u == (gen + 1u) * nloc) {
            if (!light) {
            __builtin_amdgcn_fence(__ATOMIC_RELEASE, "agent");
            asm volatile("s_waitcnt vmcnt(0)" ::: "memory");
            const unsigned og = xb_add(&bar[XB_TOP], 1u);
            const unsigned tg = og / nx;
            if (og + 1u == (tg + 1u) * nx) xb_add(&bar[XB_TOPGEN], 1u);
            else XB_SPIN(xb_ld(&bar[XB_TOPGEN]) == tg, bar);
            }
            __builtin_amdgcn_fence(__ATOMIC_ACQUIRE, "agent");
            xb_add(&bar[XB_XGEN(b.x)], 1u);
            asm volatile("s_waitcnt vmcnt(0)" ::: "memory");
        } else {
            XB_SPIN(xb_ld(&bar[XB_XGEN(b.x)]) == gen, bar);
            __builtin_amdgcn_fence(__ATOMIC_ACQUIRE, "agent");
            asm volatile("s_waitcnt vmcnt(0)" ::: "memory");
        }
    }
    __syncthreads();
}

#ifndef MK_PROBE_REP
#define MK_PROBE_REP 0u
#endif
#ifndef MK_PROBE_L
#define MK_PROBE_L -1
#endif
#ifndef MK_XCD_BARRIER
#define MK_XCD_BARRIER 1
#endif
#ifndef MK_PER_PHASE
#define MK_PER_PHASE 0
#endif
constexpr int RING_BYTES = 131072, LDS_BYTES = 150528;
constexpr int PPL = 8;
constexpr int NPHASE = 1 + PPL * DEPTH;
struct Args { Ctx c; int ph_lo, ph_hi; };
namespace cg = cooperative_groups;

typedef const __attribute__((address_space(4))) Args* KArgsP;
#define LOAD_CTX() Ctx c; c.x = kp->c.x; c.rel_bias = kp->c.rel_bias; c.norm_mix_g = kp->c.norm_mix_g; c.w_in = kp->c.w_in; c.pool_w = kp->c.pool_w; c.pool_scale = kp->c.pool_scale; \
    c.w_proj_attn = kp->c.w_proj_attn; c.w_proj_pool = kp->c.w_proj_pool; c.w_out = kp->c.w_out; c.norm_ffn_g = kp->c.norm_ffn_g; c.w_rg = kp->c.w_rg; c.w_re = kp->c.w_re; \
    c.w_gate = kp->c.w_gate; c.w_up = kp->c.w_up; c.w_down = kp->c.w_down; c.norm_final_g = kp->c.norm_final_g; c.out = kp->c.out; c.ws = kp->c.ws
template <int KIND> __device__ __forceinline__ void run_phase(KArgsP kp, int l, LAS unsigned char* lds, int wv) {
    asm volatile("" : "+s"(kp));
    const int G_ = gridDim.x;
    int bx = blockIdx.x;
    int vcu = (G_ % 8 == 0) ? (bx % 8) * (G_ / 8) + bx / 8 : bx;
#if MK_XCD_BARRIER && !MK_PER_PHASE
    if constexpr (KIND != -1) { LAS const unsigned* misc = (LAS const unsigned*)(lds + RING_BYTES);
        vcu = __builtin_amdgcn_readfirstlane((int)misc[12]); bx = __builtin_amdgcn_readfirstlane((int)misc[13]); }
#endif
    LOAD_CTX();
    if constexpr (KIND == -1) ph_prologue(c, vcu, G_, lds, wv);
    else if constexpr (KIND == 0) { pg8::Gemm g{c.H(), c.WIN() + (size_t)l * NIN * D, T, NIN, D}; pg8::StaticOrder S; S.init(T, NIN, G_, bx);
        pg8::EpiProj E{c.PROJ(), c.RSTDM()}; pg8::gemm_phase<pg8::EpiProj, pg8::StaticOrder, true, true>(lds, g, S, E, wv); }
    else if constexpr (KIND == 1) { ph_attention(c, vcu, G_, lds, wv); ph_pool(c, vcu, G_, lds, wv); }
    else if constexpr (KIND == 2) { }
    else if constexpr (KIND == 3) { pg8::Gemm g{c.A2(), c.WP() + (size_t)l * D * A2W, T, D, A2W}; pg8::StaticOrder S; S.init(T, D, G_, bx);
        {
            pg8::Unit u; if (S.next(0, u)) {
                ph_merge64(c, u.pm * 256 + u.pn * 64, wv);
                asm volatile("s_waitcnt vmcnt(0)" ::: "memory"); __syncthreads();
                if (opaque_tid(wv) == 0) { int* pc = c.PANEL() + (l * 64 + u.pm) * 16;
                    __hip_atomic_fetch_add(pc, 1, __ATOMIC_RELAXED, __HIP_MEMORY_SCOPE_AGENT);
                    unsigned sp = 0; while (__hip_atomic_load(pc, __ATOMIC_RELAXED, __HIP_MEMORY_SCOPE_AGENT) < 4) { __builtin_amdgcn_s_sleep(1); if (++sp > (1u << 22)) break; }
                    __builtin_amdgcn_fence(__ATOMIC_ACQUIRE, "agent"); asm volatile("s_waitcnt vmcnt(0)" ::: "memory"); }
                __syncthreads(); } }
        pg8::EpiGate E{c.PROJ(), c.Y()}; pg8::gemm_phase<pg8::EpiGate, pg8::StaticOrder, true, true>(lds, g, S, E, wv); }
    else if constexpr (KIND == 4) { pg8::Gemm g{c.Y(), c.WOUT() + (size_t)l * D * D, T, D, D}; pg8::StaticOrder S; S.init(T, D, G_, bx);
        pg8::EpiRes<false> E{c.x, c.H(), c.H()}; pg8::gemm_phase<pg8::EpiRes<false>, pg8::StaticOrder, true, true>(lds, g, S, E, wv); }
    else if constexpr (KIND == 5) ph_router(c, l, vcu, G_, lds, wv);
    else if constexpr (KIND == 6) ph_scatter(c, l, vcu, G_, (LAS int*)lds, wv);
    else if constexpr (KIND == 7) { const int ntiles = __builtin_amdgcn_readfirstlane(__hip_atomic_load(c.META(), __ATOMIC_RELAXED, __HIP_MEMORY_SCOPE_AGENT));
        moe::gemm_phase<0>(lds, c.H(), D, c.w_gate + (size_t)l * NE * D * DE, c.w_up + (size_t)l * NE * D * DE, c.HB(), c.TILEE(), c.SRC(), c.RS(), c.norm_ffn_g + (size_t)l * D, c.READY() + l * 256, ntiles, G_, vcu, wv);
        moe::gemm_phase<1>(lds, c.HB(), DE, c.w_down + (size_t)l * NE * DE * D, c.w_down + (size_t)l * NE * DE * D, c.YPAD(), c.TILEE(), c.SRC(), c.RS(), c.norm_ffn_g, c.READY() + l * 256, ntiles, G_, vcu, wv); }
    else if constexpr (KIND == 8) { }
    else ph_combine(c, l, vcu, G_, wv);
}
__device__ __forceinline__ void seam(KArgsP kp, LAS unsigned char* lds, int wv, bool light = false) {
    const bool t0 = (opaque_tid(wv) == 0);
#if MK_XCD_BARRIER
    XcdBarrier b; b.bar = (unsigned*)(kp->c.ws + WS_CTL + CT_BAR); b.x = xb_xcc_id(); b.st = (volatile LAS unsigned*)(lds + RING_BYTES) + 8;
#if !MK_PER_PHASE
    light = light && (b.st[3] != 0u);
#else
    light = false;
#endif
    xcd_barrier(b, t0, light);
#else
    cg::this_grid().sync();
#endif
}
__device__ __forceinline__ void setup_map(KArgsP kp, LAS unsigned char* lds, int wv) {
#if MK_XCD_BARRIER && !MK_PER_PHASE
    volatile LAS unsigned* misc = (volatile LAS unsigned*)(lds + RING_BYTES);
    if (opaque_tid(wv) == 0) {
        unsigned* bar = (unsigned*)(kp->c.ws + WS_CTL + CT_BAR);
        bool uni = (gridDim.x == 256u) && (gridDim.y * gridDim.z == 1u);
#pragma unroll
        for (unsigned j = 0; j < 16; ++j) { const unsigned cj = xb_ld(&bar[XB_XCNT(j)]); uni = uni && (cj == (j < 8u ? 32u : 0u)); }
        const unsigned x = xb_xcc_id(), r = misc[10];
        uni = uni && (x < 8u) && (r < 32u);
        const unsigned bxr = blockIdx.x;
        misc[11] = uni ? 1u : 0u;
        misc[12] = uni ? (x * 32u + r) : ((bxr % 8u) * (gridDim.x / 8u) + bxr / 8u);
        misc[13] = uni ? (r * 8u + x) : bxr;
    }
    __syncthreads();
#endif
}
__global__ void __launch_bounds__(NTHR, 2) mega(Args a) {
    extern __shared__ __attribute__((aligned(16))) unsigned char lds_raw[];
    LAS unsigned char* lds = (LAS unsigned char*)lds_raw;
    KArgsP kp = (KArgsP)__builtin_amdgcn_kernarg_segment_ptr();
#if !MK_PER_PHASE && MK_XCD_BARRIER
    const int wv = __builtin_amdgcn_readfirstlane((int)threadIdx.x >> 6);
    { volatile LAS unsigned* misc = (volatile LAS unsigned*)(lds + RING_BYTES); const int t = opaque_tid(wv);
      if (t < 16) misc[t] = 0u;
      __syncthreads();
      (void)xcd_barrier_post((unsigned*)(kp->c.ws + WS_CTL + CT_BAR), misc + 8, t == 0); }
#endif
    const int ph_lo = kp->ph_lo, ph_hi = kp->ph_hi;
#define LIGHT_SEAM(ph_) ((((ph_) - 1) % PPL >= 1 && ((ph_) - 1) % PPL <= 4) || (((ph_) - 1) % PPL == 0 && (ph_) > 1))
#define RUN(ph, KIND, L) do { const int ph_ = (ph); if (ph_lo <= ph_ && ph_ < ph_hi) { if (ph_ > ph_lo) seam(kp, lds, wv, LIGHT_SEAM(ph_)); if (ph_ == 1 && ph_lo == 0) setup_map(kp, lds, wv); run_phase<KIND>(kp, (L), lds, wv); \
        if (((MK_PROBE_REP >> ((KIND) + 1)) & 1) && (MK_PROBE_L < 0 || (L) == MK_PROBE_L)) { seam(kp, lds, wv); run_phase<KIND>(kp, (L), lds, wv); } } } while (0)
    RUN(0, -1, 0);
#define LAYER(l) do { constexpr int b0 = 1 + PPL * (l); \
        RUN(b0 + 0, 0, l); RUN(b0 + 1, 1, l); RUN(b0 + 2, 3, l); RUN(b0 + 3, 4, l); \
        RUN(b0 + 4, 5, l); RUN(b0 + 5, 6, l); RUN(b0 + 6, 7, l); RUN(b0 + 7, 9, l); } while (0)
    static_assert(DEPTH == 2, "two layers written out");
    LAYER(0); LAYER(1);
#undef LAYER
#undef RUN
}

extern "C" void kernel_launch(void* const* d_in, const int* in_sizes, int n_in, void* d_out, int out_size, void* d_ws, size_t ws_size, hipStream_t stream) {
    static int ready = 0;
    if (ready == 0) {
        if (n_in != 16 || in_sizes[0] != T * D || out_size != T * D || ws_size < WS_END) {
            fprintf(stderr, "kernel_launch: unexpected shapes: n_in %d in0 %d out %d ws %zu (need %zu)\n", n_in, n_in > 0 ? in_sizes[0] : -1, out_size, ws_size, (size_t)WS_END); ready = -1; return; }
        if (hipFuncSetAttribute((const void*)mega, hipFuncAttributeMaxDynamicSharedMemorySize, LDS_BYTES) != hipSuccess) { fprintf(stderr, "kernel_launch: hipFuncSetAttribute failed\n"); ready = -1; return; }
        int per_cu = 0;
        if (hipOccupancyMaxActiveBlocksPerMultiprocessor(&per_cu, (const void*)mega, NTHR, LDS_BYTES) != hipSuccess || per_cu < 1) fprintf(stderr, "kernel_launch: occupancy query says %d blocks/CU\n", per_cu);
        (void)hipGetLastError();
        ready = 1;
    }
    if (ready < 0) return;
    Args a{};
    Ctx& c = a.c;
    c.x = (const float*)d_in[0]; c.rel_bias = (const float*)d_in[1]; c.norm_mix_g = (const float*)d_in[2]; c.w_in = (const float*)d_in[3];
    c.pool_w = (const float*)d_in[4]; c.pool_scale = (const float*)d_in[5]; c.w_proj_attn = (const float*)d_in[6]; c.w_proj_pool = (const float*)d_in[7];
    c.w_out = (const float*)d_in[8]; c.norm_ffn_g = (const float*)d_in[9]; c.w_rg = (const float*)d_in[10]; c.w_re = (const float*)d_in[11];
    c.w_gate = (const float*)d_in[12]; c.w_up = (const float*)d_in[13]; c.w_down = (const float*)d_in[14]; c.norm_final_g = (const float*)d_in[15];
    c.out = (float*)d_out; c.ws = (unsigned char*)d_ws;
#if MK_PER_PHASE
    for (int ph = 0; ph < NPHASE; ++ph) { a.ph_lo = ph; a.ph_hi = ph + 1; hipLaunchKernelGGL(mega, dim3(G), dim3(NTHR), LDS_BYTES, stream, a); }
#else
    a.ph_lo = 0; a.ph_hi = NPHASE;
    if (hipMemsetAsync((char*)d_ws + WS_CTL + CT_BAR, 0, CT_BAR_BYTES, stream) != hipSuccess) { fprintf(stderr, "kernel_launch: hipMemsetAsync failed\n"); return; }
    void* args[] = {&a};
    hipError_t e = hipLaunchCooperativeKernel((const void*)mega, dim3(G), dim3(NTHR), args, LDS_BYTES, stream);
    if (e != hipSuccess) fprintf(stderr, "cooperative launch failed: %s\n", hipGetErrorString(e));
#endif
}
```
